# Optimizing an MI355X kernel written in HIP

```python
import math
import jax, jax.numpy as jnp
from jax import lax
import numpy as np

D_MODEL = 1024
BATCH = 16
SEQ = 2048
DEPTH = 2

MEM_LEN = 256
D_MIX = D_MODEL
D_SSM = (3 * D_MIX) // 8
D_POOL = D_MIX // 4
D_CONV = D_MIX - D_SSM - D_POOL
SSM_GROUP = 16
N_SSM_GROUPS = D_SSM // SSM_GROUP
SSM_STATE = 64
POOL_WINDOWS = (2, 4, 8, 16)
N_POOL_GROUPS = len(POOL_WINDOWS)
POOL_GROUP = D_POOL // N_POOL_GROUPS
CONV_WIDTH = 31
D_IN = D_SSM + D_POOL + 2 * D_CONV
D_FF = 2816
N_XHEADS = 4
XHEAD_DIM = D_MODEL // N_XHEADS
EPS = 1e-6
DT_MIN = 1e-3
DT_MAX = 1e-1

kernel_name = "hybrid_s5_pool_conv_macaron_xattn"


def rmsnorm(x, g):
    xf = x.astype(jnp.float32)
    y = xf * lax.rsqrt(jnp.mean(xf * xf, axis=-1, keepdims=True) + EPS)
    return (y * g.astype(jnp.float32)).astype(x.dtype)


def swiglu_ffn(h, w_gate, w_up, w_down):
    return (jax.nn.silu(h @ w_gate) * (h @ w_up)) @ w_down


def _complex_linear_combine(c1, c2):
    ar1, ai1, br1, bi1 = c1
    ar2, ai2, br2, bi2 = c2
    ar = ar2 * ar1 - ai2 * ai1
    ai = ar2 * ai1 + ai2 * ar1
    br = ar2 * br1 - ai2 * bi1 + br2
    bi = ar2 * bi1 + ai2 * br1 + bi2
    return (ar, ai, br, bi)


def s5_mixer(u, lam_re, lam_im, log_dt, b_re, b_im, c_re, c_im, d, w_glu):
    bsz, s, _ = u.shape
    f32 = jnp.float32
    uf = u.astype(f32)
    ug = uf.reshape(bsz, s, N_SSM_GROUPS, SSM_GROUP)
    lr = lam_re.astype(f32)
    li = lam_im.astype(f32)
    dt = jnp.exp(log_dt.astype(f32))[:, None]
    mag = jnp.exp(lr * dt)
    ar = mag * jnp.cos(li * dt)
    ai = mag * jnp.sin(li * dt)
    den = lr * lr + li * li
    zr = ((ar - 1.0) * lr + ai * li) / den
    zi = (ai * lr - (ar - 1.0) * li) / den
    br_ = b_re.astype(f32)
    bi_ = b_im.astype(f32)
    bbar_r = zr[..., None] * br_ - zi[..., None] * bi_
    bbar_i = zr[..., None] * bi_ + zi[..., None] * br_
    bu_r = jnp.einsum('gpk,bsgk->bsgp', bbar_r, ug)
    bu_i = jnp.einsum('gpk,bsgk->bsgp', bbar_i, ug)
    a_r = jnp.broadcast_to(ar[None, None], (1, s, N_SSM_GROUPS, SSM_STATE))
    a_i = jnp.broadcast_to(ai[None, None], (1, s, N_SSM_GROUPS, SSM_STATE))
    _, _, x_r, x_i = lax.associative_scan(_complex_linear_combine, (a_r, a_i, bu_r, bu_i), axis=1)
    y = (jnp.einsum('gkp,bsgp->bsgk', c_re.astype(f32), x_r)
         - jnp.einsum('gkp,bsgp->bsgk', c_im.astype(f32), x_i))
    y = y.reshape(bsz, s, D_SSM) + d.astype(f32) * uf
    y = jax.nn.gelu(y)
    out = y * jax.nn.sigmoid(y @ w_glu.astype(f32))
    return out.astype(u.dtype)


def pool_mixer(u, w_pool, pool_scale):
    bsz, s, _ = u.shape
    uf = u.astype(jnp.float32)
    cs = jnp.cumsum(uf, axis=1)
    pos = jnp.arange(1, s + 1, dtype=jnp.float32)[None, :, None]
    outs = []
    for gi, w in enumerate(POOL_WINDOWS):
        c = cs[..., gi * POOL_GROUP:(gi + 1) * POOL_GROUP]
        prev = jnp.pad(c[:, :-w], ((0, 0), (w, 0), (0, 0)))
        mean = (c - prev) / jnp.minimum(pos, float(w))
        outs.append(mean - uf[..., gi * POOL_GROUP:(gi + 1) * POOL_GROUP])
    p = jnp.stack(outs, axis=2)
    p = jnp.einsum('bsgc,gcd->bsgd', p, w_pool.astype(jnp.float32)).reshape(bsz, s, D_POOL)
    return (p * pool_scale.astype(jnp.float32)).astype(u.dtype)


def conv_module(v, g, conv_w, conv_b, ln_g, ln_b):
    h = v * jax.nn.sigmoid(g)
    h = lax.conv_general_dilated(
        h, conv_w[:, None, :].astype(h.dtype), window_strides=(1,),
        padding=[(CONV_WIDTH - 1, 0)], dimension_numbers=('NWC', 'WIO', 'NWC'),
        feature_group_count=D_CONV) + conv_b
    hf = h.astype(jnp.float32)
    mu = jnp.mean(hf, axis=-1, keepdims=True)
    var = jnp.mean(jnp.square(hf - mu), axis=-1, keepdims=True)
    hf = (hf - mu) * lax.rsqrt(var + EPS) * ln_g.astype(jnp.float32) + ln_b.astype(jnp.float32)
    return jax.nn.silu(hf).astype(v.dtype)


def cross_attention(h, m, wq, wk, wv, wo):
    bsz, s, _ = h.shape
    mlen = m.shape[1]
    q = (h @ wq).reshape(bsz, s, N_XHEADS, XHEAD_DIM)
    k = (m @ wk).reshape(bsz, mlen, N_XHEADS, XHEAD_DIM)
    v = (m @ wv).reshape(bsz, mlen, N_XHEADS, XHEAD_DIM)
    scores = jnp.einsum('bshd,bmhd->bhsm', q, k).astype(jnp.float32) * (XHEAD_DIM ** -0.5)
    probs = jax.nn.softmax(scores, axis=-1).astype(v.dtype)
    o = jnp.einsum('bhsm,bmhd->bshd', probs, v).reshape(bsz, s, D_MODEL)
    return o @ wo


def setup_inputs(seed: int = 0) -> dict:
    key = jax.random.key(seed)
    ks = iter(jax.random.split(key, 48))
    L = DEPTH

    def nrm(shape, scale):
        return jax.random.normal(next(ks), shape, jnp.float32) * scale

    def gain(shape):
        return 1.0 + 0.05 * jax.random.normal(next(ks), shape, jnp.float32)

    inp = {}
    inp["x"] = nrm((BATCH, SEQ, D_MODEL), 1.0)
    inp["mem"] = nrm((BATCH, MEM_LEN, D_MODEL), 1.0)
    inp["ffn1_norm"] = gain((L, D_MODEL))
    inp["ffn1_w_gate"] = nrm((L, D_MODEL, D_FF), D_MODEL ** -0.5)
    inp["ffn1_w_up"] = nrm((L, D_MODEL, D_FF), D_MODEL ** -0.5)
    inp["ffn1_w_down"] = nrm((L, D_FF, D_MODEL), D_FF ** -0.5)
    inp["mix_norm"] = gain((L, D_MODEL))
    inp["w_in"] = nrm((L, D_MODEL, D_IN), D_MODEL ** -0.5)
    inp["w_out"] = nrm((L, D_MIX, D_MODEL), D_MIX ** -0.5)
    inp["ssm_lambda_re"] = -0.5 + 0.01 * jax.random.normal(next(ks), (L, N_SSM_GROUPS, SSM_STATE), jnp.float32)
    inp["ssm_lambda_im"] = jnp.broadcast_to(
        jnp.pi * jnp.arange(SSM_STATE, dtype=jnp.float32), (L, N_SSM_GROUPS, SSM_STATE))
    inp["ssm_log_dt"] = jax.random.uniform(next(ks), (L, N_SSM_GROUPS), jnp.float32,
                                           math.log(DT_MIN), math.log(DT_MAX))
    bscale = (2.0 * SSM_GROUP) ** -0.5
    cscale = (2.0 * SSM_STATE) ** -0.5
    inp["ssm_b_re"] = nrm((L, N_SSM_GROUPS, SSM_STATE, SSM_GROUP), bscale)
    inp["ssm_b_im"] = nrm((L, N_SSM_GROUPS, SSM_STATE, SSM_GROUP), bscale)
    inp["ssm_c_re"] = nrm((L, N_SSM_GROUPS, SSM_GROUP, SSM_STATE), cscale)
    inp["ssm_c_im"] = nrm((L, N_SSM_GROUPS, SSM_GROUP, SSM_STATE), cscale)
    inp["ssm_d"] = nrm((L, D_SSM), 1.0)
    inp["ssm_w_glu"] = nrm((L, D_SSM, D_SSM), D_SSM ** -0.5)
    inp["pool_w"] = nrm((L, N_POOL_GROUPS, POOL_GROUP, POOL_GROUP), POOL_GROUP ** -0.5)
    inp["pool_scale"] = gain((L, D_POOL))
    inp["conv_w"] = nrm((L, CONV_WIDTH, D_CONV), CONV_WIDTH ** -0.5)
    inp["conv_b"] = nrm((L, D_CONV), 0.02)
    inp["conv_ln_g"] = gain((L, D_CONV))
    inp["conv_ln_b"] = nrm((L, D_CONV), 0.02)
    inp["xattn_norm"] = gain((L, D_MODEL))
    inp["mem_norm"] = gain((L, D_MODEL))
    inp["xattn_wq"] = nrm((L, D_MODEL, D_MODEL), D_MODEL ** -0.5)
    inp["xattn_wk"] = nrm((L, D_MODEL, D_MODEL), D_MODEL ** -0.5)
    inp["xattn_wv"] = nrm((L, D_MODEL, D_MODEL), D_MODEL ** -0.5)
    inp["xattn_wo"] = nrm((L, D_MODEL, D_MODEL), D_MODEL ** -0.5)
    inp["ffn2_norm"] = gain((L, D_MODEL))
    inp["ffn2_w_gate"] = nrm((L, D_MODEL, D_FF), D_MODEL ** -0.5)
    inp["ffn2_w_up"] = nrm((L, D_MODEL, D_FF), D_MODEL ** -0.5)
    inp["ffn2_w_down"] = nrm((L, D_FF, D_MODEL), D_FF ** -0.5)
    inp["final_norm"] = gain((D_MODEL,))
    return inp


def reference(x, mem, ffn1_norm, ffn1_w_gate, ffn1_w_up, ffn1_w_down, mix_norm, w_in, w_out,
              ssm_lambda_re, ssm_lambda_im, ssm_log_dt, ssm_b_re, ssm_b_im, ssm_c_re, ssm_c_im,
              ssm_d, ssm_w_glu, pool_w, pool_scale, conv_w, conv_b, conv_ln_g, conv_ln_b,
              xattn_norm, mem_norm, xattn_wq, xattn_wk, xattn_wv, xattn_wo,
              ffn2_norm, ffn2_w_gate, ffn2_w_up, ffn2_w_down, final_norm):
    split_pts = [D_SSM, D_SSM + D_POOL, D_SSM + D_POOL + D_CONV]
    for l in range(DEPTH):
        h = rmsnorm(x, ffn1_norm[l])
        x = x + 0.5 * swiglu_ffn(h, ffn1_w_gate[l], ffn1_w_up[l], ffn1_w_down[l])
        h = rmsnorm(x, mix_norm[l])
        z = h @ w_in[l]
        u_ssm, u_pool, v_conv, g_conv = jnp.split(z, split_pts, axis=-1)
        y_ssm = s5_mixer(u_ssm, ssm_lambda_re[l], ssm_lambda_im[l], ssm_log_dt[l],
                         ssm_b_re[l], ssm_b_im[l], ssm_c_re[l], ssm_c_im[l],
                         ssm_d[l], ssm_w_glu[l])
        y_pool = pool_mixer(u_pool, pool_w[l], pool_scale[l])
        y_conv = conv_module(v_conv, g_conv, conv_w[l], conv_b[l], conv_ln_g[l], conv_ln_b[l])
        y = jnp.concatenate([y_ssm, y_pool, y_conv], axis=-1)
        x = x + y @ w_out[l]
        h = rmsnorm(x, xattn_norm[l])
        m = rmsnorm(mem, mem_norm[l])
        x = x + cross_attention(h, m, xattn_wq[l], xattn_wk[l], xattn_wv[l], xattn_wo[l])
        h = rmsnorm(x, ffn2_norm[l])
        x = x + 0.5 * swiglu_ffn(h, ffn2_w_gate[l], ffn2_w_up[l], ffn2_w_down[l])
    return rmsnorm(x, final_norm)
```

```cpp
#include <hip/hip_runtime.h>
#include <hip/hip_cooperative_groups.h>
#include <cstdint>
#include <cstdio>
#include <cstring>
#ifndef REP_MASK
#define REP_MASK 0
#endif
namespace nv {
constexpr int D = 1024, NB = 16, S = 2048, M = NB * S, ML = 256, MM = NB * ML;
constexpr int DSSM = 384, DPOOL = 256, DCONV = 384, DIN = 1408, DFF = 2816, NGR = 24, SG = 16, NP = 64, CW = 31;

struct NGemm {
    const float* A; int lda; const float* B; int ldb; const float* B2; float* C; int ldc; int K;
    float alpha; const float* aux; int ldaux; const float* cs; int nh;
    long sA1, sA2, sB1, sB2, sC1, sC2;
};
__device__ __forceinline__ float sigm(float v) { return 1.f / (1.f + __expf(-v)); }

template <int EPI, int TB>
__global__ void __launch_bounds__(256) ngemm(NGemm p) {
    __shared__ float As[16][68];
    __shared__ float Bs[16][68];
    __shared__ float Bs2[EPI == 2 ? 16 : 1][68];
    const int tid = threadIdx.x, tx = tid & 15, ty = tid >> 4;
    const int z = blockIdx.z, z1 = z / p.nh, z2 = z % p.nh;
    const float* A = p.A + z1 * p.sA1 + z2 * p.sA2 + (size_t)blockIdx.y * 64 * p.lda;
    const float* B = p.B + z1 * p.sB1 + z2 * p.sB2;
    const float* B2 = p.B2;
    float* C = p.C + z1 * p.sC1 + z2 * p.sC2;
    const int n0 = blockIdx.x * 64;
    float acc[4][4], acc2[4][4];
#pragma unroll
    for (int i = 0; i < 4; ++i)
#pragma unroll
        for (int j = 0; j < 4; ++j) { acc[i][j] = 0.f; acc2[i][j] = 0.f; }
    for (int k0 = 0; k0 < p.K; k0 += 16) {
        {
            const int r = tid >> 2, kk = (tid & 3) * 4;
            const float4 v = *(const float4*)(A + (size_t)r * p.lda + k0 + kk);
            As[kk + 0][r] = v.x; As[kk + 1][r] = v.y; As[kk + 2][r] = v.z; As[kk + 3][r] = v.w;
        }
        if (TB) {
            const int n = tid >> 2, kk = (tid & 3) * 4;
            const float4 v = *(const float4*)(B + (size_t)(n0 + n) * p.ldb + k0 + kk);
            Bs[kk + 0][n] = v.x; Bs[kk + 1][n] = v.y; Bs[kk + 2][n] = v.z; Bs[kk + 3][n] = v.w;
        } else {
            const int kk = tid >> 4, n = (tid & 15) * 4;
            const float4 v = *(const float4*)(B + (size_t)(k0 + kk) * p.ldb + n0 + n);
            Bs[kk][n] = v.x; Bs[kk][n + 1] = v.y; Bs[kk][n + 2] = v.z; Bs[kk][n + 3] = v.w;
            if (EPI == 2) {
                const float4 w = *(const float4*)(B2 + (size_t)(k0 + kk) * p.ldb + n0 + n);
                Bs2[kk][n] = w.x; Bs2[kk][n + 1] = w.y; Bs2[kk][n + 2] = w.z; Bs2[kk][n + 3] = w.w;
            }
        }
        __syncthreads();
#pragma unroll
        for (int kk = 0; kk < 16; ++kk) {
            float a[4], b[4], b2[4];
#pragma unroll
            for (int i = 0; i < 4; ++i) { a[i] = As[kk][ty * 4 + i]; b[i] = Bs[kk][tx * 4 + i]; b2[i] = (EPI == 2) ? Bs2[kk][tx * 4 + i] : 0.f; }
#pragma unroll
            for (int i = 0; i < 4; ++i)
#pragma unroll
                for (int j = 0; j < 4; ++j) { acc[i][j] += a[i] * b[j]; if (EPI == 2) acc2[i][j] += a[i] * b2[j]; }
        }
        __syncthreads();
    }
#pragma unroll
    for (int i = 0; i < 4; ++i) {
        const size_t r = (size_t)blockIdx.y * 64 + ty * 4 + i;
#pragma unroll
        for (int j = 0; j < 4; ++j) {
            const int c = n0 + tx * 4 + j;
            float* o = C + r * p.ldc + c;
            const float v = acc[i][j];
            if (EPI == 0) *o = v;
            else if (EPI == 1) *o = *o + p.alpha * v;
            else if (EPI == 2) *o = v * sigm(v) * acc2[i][j];
            else if (EPI == 3) *o = p.aux[r * p.ldaux + c] * sigm(v);
            else if (EPI == 4) *o = v * p.cs[c];
            else *o = p.alpha * v;
        }
    }
}

__device__ __forceinline__ float wsum(float v) {
#pragma unroll
    for (int o = 1; o < 64; o <<= 1) v += __shfl_xor(v, o);
    return v;
}
__device__ __forceinline__ float wmax(float v) {
#pragma unroll
    for (int o = 1; o < 64; o <<= 1) v = fmaxf(v, __shfl_xor(v, o));
    return v;
}
__global__ void __launch_bounds__(256) rmsnorm_k(const float* x, const float* g, float* h, int rows) {
    const int w = (blockIdx.x * 256 + threadIdx.x) >> 6, lane = threadIdx.x & 63;
    if (w >= rows) return;
    const float4* xr = (const float4*)(x + (size_t)w * D);
    float4 v[4]; float s = 0.f;
#pragma unroll
    for (int j = 0; j < 4; ++j) { v[j] = xr[lane + 64 * j]; s += v[j].x * v[j].x + v[j].y * v[j].y + v[j].z * v[j].z + v[j].w * v[j].w; }
    const float r = rsqrtf(wsum(s) * (1.f / D) + 1e-6f);
    float4* hr = (float4*)(h + (size_t)w * D);
#pragma unroll
    for (int j = 0; j < 4; ++j) { const float4 gg = ((const float4*)g)[lane + 64 * j]; hr[lane + 64 * j] = make_float4(v[j].x * r * gg.x, v[j].y * r * gg.y, v[j].z * r * gg.z, v[j].w * r * gg.w); }
}
__global__ void copy_k(const float4* a, float4* b, size_t n4) { for (size_t i = blockIdx.x * (size_t)blockDim.x + threadIdx.x; i < n4; i += (size_t)gridDim.x * blockDim.x) b[i] = a[i]; }

__global__ void __launch_bounds__(64) s5_k(const float* z, const float* lam_re, const float* lam_im, const float* log_dt, const float* b_re, const float* b_im,
                                           const float* c_re, const float* c_im, const float* dd, float* ypre) {
    const int b = blockIdx.x / NGR, g = blockIdx.x % NGR, p = threadIdx.x;
    const float dt = expf(log_dt[g]), lr = lam_re[g * NP + p], li = lam_im[g * NP + p];
    const float mag = expf(lr * dt), ar = mag * cosf(li * dt), ai = mag * sinf(li * dt), den = lr * lr + li * li;
    const float zr = ((ar - 1.f) * lr + ai * li) / den, zi = (ai * lr - (ar - 1.f) * li) / den;
    float bbr[16], bbi[16], cr[16], ci[16];
#pragma unroll
    for (int i = 0; i < 16; ++i) {
        const float br = b_re[(g * NP + p) * SG + i], bi = b_im[(g * NP + p) * SG + i];
        bbr[i] = zr * br - zi * bi; bbi[i] = zr * bi + zi * br;
        cr[i] = c_re[(g * SG + i) * NP + p]; ci[i] = c_im[(g * SG + i) * NP + p];
    }
    const float dmine = dd[g * SG + (p & 15)];
    float xr = 0.f, xi = 0.f;
    for (int t = 0; t < S; ++t) {
        const size_t row = (size_t)b * S + t;
        const float4* up = (const float4*)(z + row * DIN + g * SG);
        const float4 u0 = up[0], u1 = up[1], u2 = up[2], u3 = up[3];
        const float u[16] = {u0.x, u0.y, u0.z, u0.w, u1.x, u1.y, u1.z, u1.w, u2.x, u2.y, u2.z, u2.w, u3.x, u3.y, u3.z, u3.w};
        float bur = 0.f, bui = 0.f;
#pragma unroll
        for (int i = 0; i < 16; ++i) { bur += bbr[i] * u[i]; bui += bbi[i] * u[i]; }
        const float nxr = ar * xr - ai * xi + bur, nxi = ar * xi + ai * xr + bui;
        xr = nxr; xi = nxi;
        float mine = 0.f, umine = 0.f;
#pragma unroll
        for (int o = 0; o < 16; ++o) { const float sv = wsum(cr[o] * xr - ci[o] * xi); if (p == o) { mine = sv; umine = u[o]; } }
        if (p < 16) {
            const float v = mine + dmine * umine;
            ypre[row * DSSM + g * SG + p] = 0.5f * v * (1.f + tanhf(0.7978845608028654f * (v + 0.044715f * v * v * v)));
        }
    }
}
__global__ void pool_k(const float* z, float* pp) {
    const size_t i = blockIdx.x * (size_t)blockDim.x + threadIdx.x;
    if (i >= (size_t)M * DPOOL) return;
    const size_t row = i / DPOOL; const int c = (int)(i % DPOOL), t = (int)(row % S), w = 2 << (c / 64);
    const int n = (t + 1 < w) ? t + 1 : w;
    float s = 0.f;
    for (int j = 0; j < n; ++j) s += z[(row - j) * DIN + DSSM + c];
    pp[i] = s / (float)n - z[row * DIN + DSSM + c];
}
__global__ void conv_k(const float* z, const float* cw, const float* cbias, float* cb) {
    const size_t i = blockIdx.x * (size_t)blockDim.x + threadIdx.x;
    if (i >= (size_t)M * DCONV) return;
    const size_t row = i / DCONV; const int c = (int)(i % DCONV), t = (int)(row % S);
    float s = cbias[c];
    for (int j = 0; j < CW; ++j) {
        const int tt = t - (CW - 1) + j;
        if (tt < 0) continue;
        const size_t r2 = row - (CW - 1) + j;
        const float v = z[r2 * DIN + DSSM + DPOOL + c], g = z[r2 * DIN + DSSM + DPOOL + DCONV + c];
        s += cw[j * DCONV + c] * v * sigm(g);
    }
    cb[i] = s;
}
__global__ void __launch_bounds__(256) convln_k(const float* cb, const float* g, const float* bta, float* ymix) {
    const int w = (blockIdx.x * 256 + threadIdx.x) >> 6, lane = threadIdx.x & 63;
    if (w >= M) return;
    float v[6]; float s = 0.f;
#pragma unroll
    for (int j = 0; j < 6; ++j) { v[j] = cb[(size_t)w * DCONV + lane + 64 * j]; s += v[j]; }
    const float mu = wsum(s) * (1.f / DCONV); float q = 0.f;
#pragma unroll
    for (int j = 0; j < 6; ++j) { v[j] -= mu; q += v[j] * v[j]; }
    const float r = rsqrtf(wsum(q) * (1.f / DCONV) + 1e-6f);
#pragma unroll
    for (int j = 0; j < 6; ++j) { const int c = lane + 64 * j; const float h = v[j] * r * g[c] + bta[c]; ymix[(size_t)w * D + DSSM + DPOOL + c] = h * sigm(h); }
}
__global__ void __launch_bounds__(256) softmax_k(float* sc, size_t rows) {
    const size_t w = (blockIdx.x * (size_t)256 + threadIdx.x) >> 6; const int lane = threadIdx.x & 63;
    if (w >= rows) return;
    float4* r = (float4*)(sc + w * 256);
    float4 v = r[lane];
    const float mx = wmax(fmaxf(fmaxf(v.x, v.y), fmaxf(v.z, v.w)));
    v.x = __expf(v.x - mx); v.y = __expf(v.y - mx); v.z = __expf(v.z - mx); v.w = __expf(v.w - mx);
    const float inv = 1.f / wsum(v.x + v.y + v.z + v.w);
    r[lane] = make_float4(v.x * inv, v.y * inv, v.z * inv, v.w * inv);
}

struct In {
    const float *x, *mem, *ffn1_norm, *ffn1_wg, *ffn1_wu, *ffn1_wd, *mix_norm, *w_in, *w_out, *lam_re, *lam_im, *log_dt, *b_re, *b_im, *c_re, *c_im, *ssm_d, *w_glu,
        *pool_w, *pool_scale, *conv_w, *conv_b, *ln_g, *ln_b, *xattn_norm, *mem_norm, *wq, *wk, *wv, *wo, *ffn2_norm, *ffn2_wg, *ffn2_wu, *ffn2_wd, *final_norm;
};
static In make_in(void* const* d) {
    In I; const float** f = (const float**)&I;
    for (int i = 0; i < 35; ++i) f[i] = (const float*)d[i];
    return I;
}
template <int EPI, int TB>
static void gemm(hipStream_t st, int Mr, int N, int K, const float* A, int lda, const float* B, int ldb, float* C, int ldc, float alpha = 1.f, const float* B2 = nullptr,
                 const float* aux = nullptr, int ldaux = 0, const float* cs = nullptr, int nz = 1, int nh = 1, long sA1 = 0, long sA2 = 0, long sB1 = 0, long sB2 = 0, long sC1 = 0, long sC2 = 0) {
    NGemm p; memset(&p, 0, sizeof(p));
    p.A = A; p.lda = lda; p.B = B; p.ldb = ldb; p.B2 = B2; p.C = C; p.ldc = ldc; p.K = K; p.alpha = alpha; p.aux = aux; p.ldaux = ldaux; p.cs = cs; p.nh = nh;
    p.sA1 = sA1; p.sA2 = sA2; p.sB1 = sB1; p.sB2 = sB2; p.sC1 = sC1; p.sC2 = sC2;
    hipLaunchKernelGGL((ngemm<EPI, TB>), dim3(N / 64, Mr / 64, nz), dim3(256), 0, st, p);
}
constexpr size_t R0 = 0, R1 = (size_t)M * D, R2 = R1 + (size_t)M * DIN, R3 = R2 + (size_t)M * D, REND = R3 + (size_t)M * DSSM;

static void ffn(hipStream_t st, float* x, float* ws, const float* nrm, const float* wg, const float* wu, const float* wd) {
    float* h = ws + R0; float* act = ws + R1;
    hipLaunchKernelGGL(rmsnorm_k, dim3(M / 4), dim3(256), 0, st, x, nrm, h, M);
    for (int ch = 0; ch < 4; ++ch) {
        gemm<2, 0>(st, M, 704, D, h, D, wg + ch * 704, DFF, act, 704, 1.f, wu + ch * 704);
        gemm<1, 0>(st, M, D, 704, act, 704, wd + (size_t)ch * 704 * D, D, x, D, 0.5f);
    }
}
static void mixer(hipStream_t st, float* x, float* ws, const In& I, int l) {
    float* h = ws + R0; float* z = ws + R1; float* ymix = ws + R2; float* ypre = ws + R3; float* pp = ws + R0; float* cb = ws + R0 + (size_t)M * DPOOL;
    hipLaunchKernelGGL(rmsnorm_k, dim3(M / 4), dim3(256), 0, st, x, I.mix_norm + l * D, h, M);
    gemm<0, 0>(st, M, DIN, D, h, D, I.w_in + (size_t)l * D * DIN, DIN, z, DIN);
    hipLaunchKernelGGL(s5_k, dim3(NB * NGR), dim3(64), 0, st, z, I.lam_re + l * NGR * NP, I.lam_im + l * NGR * NP, I.log_dt + l * NGR, I.b_re + (size_t)l * NGR * NP * SG, I.b_im + (size_t)l * NGR * NP * SG,
                       I.c_re + (size_t)l * NGR * SG * NP, I.c_im + (size_t)l * NGR * SG * NP, I.ssm_d + l * DSSM, ypre);
    gemm<3, 0>(st, M, DSSM, DSSM, ypre, DSSM, I.w_glu + (size_t)l * DSSM * DSSM, DSSM, ymix, D, 1.f, nullptr, ypre, DSSM);
    hipLaunchKernelGGL(pool_k, dim3((M * DPOOL) / 256), dim3(256), 0, st, z, pp);
    for (int g = 0; g < 4; ++g)
        gemm<4, 0>(st, M, 64, 64, pp + g * 64, DPOOL, I.pool_w + (size_t)(l * 4 + g) * 64 * 64, 64, ymix + DSSM + g * 64, D, 1.f, nullptr, nullptr, 0, I.pool_scale + l * DPOOL + g * 64);
    hipLaunchKernelGGL(conv_k, dim3((M * DCONV) / 256), dim3(256), 0, st, z, I.conv_w + (size_t)l * CW * DCONV, I.conv_b + l * DCONV, cb);
    hipLaunchKernelGGL(convln_k, dim3(M / 4), dim3(256), 0, st, cb, I.ln_g + l * DCONV, I.ln_b + l * DCONV, ymix);
    gemm<1, 0>(st, M, D, D, ymix, D, I.w_out + (size_t)l * D * D, D, x, D, 1.f);
}
static void xattn(hipStream_t st, float* x, float* ws, const In& I, int l) {
    float* h = ws + R0; float* q = ws + R2; float* mn = ws + R3; float* k = ws + R3 + (size_t)MM * D; float* v = ws + R3 + (size_t)2 * MM * D; float* sc = ws + R1; float* o = ws + R0;
    hipLaunchKernelGGL(rmsnorm_k, dim3(M / 4), dim3(256), 0, st, x, I.xattn_norm + l * D, h, M);
    hipLaunchKernelGGL(rmsnorm_k, dim3(MM / 4), dim3(256), 0, st, I.mem, I.mem_norm + l * D, mn, MM);
    gemm<0, 0>(st, M, D, D, h, D, I.wq + (size_t)l * D * D, D, q, D);
    gemm<0, 0>(st, MM, D, D, mn, D, I.wk + (size_t)l * D * D, D, k, D);
    gemm<0, 0>(st, MM, D, D, mn, D, I.wv + (size_t)l * D * D, D, v, D);
    gemm<5, 1>(st, S, ML, 256, q, D, k, D, sc, ML, 1.f / 16.f, nullptr, nullptr, 0, nullptr, NB * 4, 4, (long)S * D, 256, (long)ML * D, 256, (long)4 * S * ML, (long)S * ML);
    hipLaunchKernelGGL(softmax_k, dim3((unsigned)((size_t)NB * 4 * S / 4)), dim3(256), 0, st, sc, (size_t)NB * 4 * S);
    gemm<0, 0>(st, S, 256, ML, sc, ML, v, D, o, D, 1.f, nullptr, nullptr, 0, nullptr, NB * 4, 4, (long)4 * S * ML, (long)S * ML, (long)ML * D, 256, (long)S * D, 256);
    gemm<1, 0>(st, M, D, D, o, D, I.wo + (size_t)l * D * D, D, x, D, 1.f);
}
static void forward(hipStream_t st, void* const* d_in, float* out, float* ws) {
    const In I = make_in(d_in);
    float* x = out;
    hipLaunchKernelGGL(copy_k, dim3(4096), dim3(256), 0, st, (const float4*)I.x, (float4*)x, (size_t)M * D / 4);
    for (int l = 0; l < 2; ++l) {
        ffn(st, x, ws, I.ffn1_norm + l * D, I.ffn1_wg + (size_t)l * D * DFF, I.ffn1_wu + (size_t)l * D * DFF, I.ffn1_wd + (size_t)l * DFF * D);
        mixer(st, x, ws, I, l);
        xattn(st, x, ws, I, l);
        ffn(st, x, ws, I.ffn2_norm + l * D, I.ffn2_wg + (size_t)l * D * DFF, I.ffn2_wu + (size_t)l * D * DFF, I.ffn2_wd + (size_t)l * DFF * D);
    }
    hipLaunchKernelGGL(rmsnorm_k, dim3(M / 4), dim3(256), 0, st, x, I.final_norm, x, M);
}
}
namespace mk {
namespace cg = cooperative_groups;
#define LAS __attribute__((address_space(3)))
#define GAS __attribute__((address_space(1)))
typedef unsigned short bf16_t;
typedef short bf16x8 __attribute__((ext_vector_type(8)));
typedef float f32x4 __attribute__((ext_vector_type(4)));
typedef float f32x2 __attribute__((ext_vector_type(2)));
typedef unsigned u32x4 __attribute__((ext_vector_type(4)));
typedef unsigned u32x2 __attribute__((ext_vector_type(2)));
constexpr int BM = 256, BK = 64, HALF = 128, HTB = HALF * BK * 2, STAGE_BYTES = 8 * HTB, NXCD = 8, WGM = 8;
constexpr int XCH_OFF = STAGE_BYTES, MISC_OFF = 147456, LDS_BYTES = MISC_OFF + 256;

constexpr int D = 1024, NB = 16, S = 2048, M = NB * S, ML = 256, MM = NB * ML;
constexpr int DSSM = 384, DPOOL = 256, DCONV = 384, DIN = 1408, DFF = 2816, NGR = 24, SG = 16, NP = 64, CW = 31;
constexpr int CH = 32  , NCH = M / CH  , NTOK = CH * SG  , KCAT = 128 + NTOK  , GROWS = NGR * NCH  ;
constexpr float EPS = 1e-6f;

constexpr size_t MiB = 1u << 20;
constexpr size_t WS_CTL = 0;
constexpr size_t WS_WL = 1 * MiB;
constexpr size_t WL_GU1 = 0, WL_D1 = 11 * MiB, WL_GU2 = WL_D1 + 5767168, WL_D2 = WL_GU2 + 11 * MiB, WL_IN = WL_D2 + 5767168, WL_OUT = WL_IN + 3 * MiB,
                 WL_Q = WL_OUT + 2 * MiB, WL_K = WL_Q + 2 * MiB, WL_V = WL_K + 2 * MiB, WL_O = WL_V + 2 * MiB, WL_GLU = WL_O + 2 * MiB, WL_GM = WL_GLU + MiB / 2,
                 WL_STRIDE = WL_GM + 6553600;
constexpr size_t WS_KTAB = WS_WL + 2 * WL_STRIDE;
constexpr size_t WS_TCAT = WS_KTAB + 3 * MiB;
constexpr size_t WS_XB = WS_TCAT + 54 * MiB;
constexpr size_t WS_ARENA = WS_XB + 64 * MiB;
constexpr size_t WS_ACT = WS_ARENA;
constexpr size_t WS_UCAT = WS_ARENA;
constexpr size_t WS_ZPC = WS_UCAT + 30 * MiB;
constexpr size_t WS_Q = WS_ZPC;
constexpr size_t WS_YG = WS_ZPC + 64 * MiB;
constexpr size_t WS_YMIX = WS_YG + 24 * MiB;
constexpr size_t WS_XLOC = WS_YMIX + 64 * MiB;
constexpr size_t WS_KV = WS_ARENA + 194 * MiB;
constexpr size_t WS_MEMB = WS_KV + 32 * MiB;
constexpr size_t WS_RSMEM = WS_MEMB + 8 * MiB;
constexpr size_t WS_SSQ = WS_RSMEM + 1 * MiB;
constexpr size_t WS_END = WS_SSQ + 2 * MiB;
static_assert(WS_ACT + (size_t)M * DFF * 2 <= WS_KV && WS_XLOC + (size_t)GROWS * 128 * 4 <= WS_KV && WS_UCAT + (size_t)GROWS * KCAT * 2 <= WS_ZPC && (size_t)NGR * NTOK * KCAT * 2 <= 54 * MiB, "arena");
static_assert(WS_END <= 500 * MiB, "ws");

__host__ __device__ __forceinline__ int lds_byte(int r, int c) { const int st = (r >> 4) * 2 + (c >> 5), rr = r & 15, cc = c & 31, ob = rr * 64 + cc * 2; return st * 1024 + (ob ^ (((ob >> 9) & 1) << 5)); }
__host__ __device__ __forceinline__ void stage_rc(int b, int& R, int& C) { const int st = b / 1024, sb = b % 1024, swz = sb ^ (((sb >> 9) & 1) << 5); R = (st >> 1) * 16 + swz / 64; C = (st & 1) * 32 + (swz % 64) / 2; }
__host__ __device__ __forceinline__ int perm32(int rho) { const int n = rho >> 4, i = rho & 15; return 8 * (i >> 2) + 4 * n + (i & 3); }

struct Unit { int pm, pn, kind, nt; size_t aoff, boff; };
struct Gemm { const unsigned char* A; const unsigned char* Bt; int lda, ldb, K; int a_blocked, b_blocked; };

struct Sched {
    int nM, nN, nwg, G, c, kv, bdiv, causal;
    size_t a0, aM, aN, b0, bM, bN;
    size_t kv_memb, kv_wk0, kv_wk1, kv_wv0, kv_wv1;
    __device__ __forceinline__ void init(int nM_, int nN_, int G_, int c_) { nM = nM_; nN = nN_; nwg = nM * nN; G = G_; c = c_; kv = 0; bdiv = 1; causal = 0; a0 = aM = aN = b0 = bM = bN = 0; kv_memb = kv_wk0 = kv_wk1 = kv_wv0 = kv_wv1 = 0; }
    __device__ __forceinline__ bool next(int i, Unit& u) const {
        const long L = (long)i * G + c; if (L >= nwg) return false;
        if (kv) {
            const int sub = (int)L >> 6, r = (int)L & 63; u.kind = sub; u.nt = 0;
            if ((sub & 1) == 0) { u.pm = r >> 2; u.pn = r & 3; u.aoff = kv_memb + (size_t)u.pm * 524288; u.boff = (sub ? kv_wk1 : kv_wk0) + (size_t)u.pn * 524288; }
            else { u.pm = r >> 4; u.pn = r & 15; u.aoff = (sub == 3 ? kv_wv1 : kv_wv0) + (size_t)u.pm * 524288; u.boff = kv_memb + (size_t)u.pn * 524288; }
            return true;
        }
        int wgid = (int)L; { const int q = nwg / NXCD, r = nwg % NXCD, xcd = wgid % NXCD, off = wgid / NXCD; wgid = (xcd < r ? xcd * (q + 1) : r * (q + 1) + (xcd - r) * q) + off; }
        const int nig = WGM * nN, gid = wgid / nig, fm = gid * WGM, gsz = (nM - fm) < WGM ? (nM - fm) : WGM;
        u.pm = fm + ((wgid % nig) % gsz); u.pn = (wgid % nig) / gsz; u.kind = 0; u.nt = causal ? 2 + 4 * (u.pn + 1) : 0;
        u.aoff = a0 + (size_t)u.pm * aM + (size_t)u.pn * aN; u.boff = b0 + (size_t)u.pn * bN + (size_t)(u.pm / bdiv) * bM;
        return true;
    }
};

__device__ __forceinline__ unsigned cvt_pk_bf16(float lo, float hi) { unsigned r; asm volatile("v_cvt_pk_bf16_f32 %0, %1, %2" : "=v"(r) : "v"(lo), "v"(hi)); return r; }
__device__ __forceinline__ float bf_lo(unsigned w) { return __uint_as_float(w << 16); }
__device__ __forceinline__ float bf_hi(unsigned w) { return __uint_as_float(w & 0xffff0000u); }
__device__ __forceinline__ float fsigm(float v) { return __builtin_amdgcn_rcpf(1.f + __builtin_amdgcn_exp2f(-1.4426950408889634f * v)); }
__device__ __forceinline__ float gelu_tanh(float v) { return v * fsigm(1.5957691216057308f * (v + 0.044715f * v * v * v)); }
__device__ __forceinline__ u32x4 pack8(f32x4 a, f32x4 b) { u32x4 w; w.x = cvt_pk_bf16(a[0], a[1]); w.y = cvt_pk_bf16(a[2], a[3]); w.z = cvt_pk_bf16(b[0], b[1]); w.w = cvt_pk_bf16(b[2], b[3]); return w; }
__device__ __forceinline__ void unpack8(u32x4 w, f32x4& a, f32x4& b) { a = (f32x4){bf_lo(w.x), bf_hi(w.x), bf_lo(w.y), bf_hi(w.y)}; b = (f32x4){bf_lo(w.z), bf_hi(w.z), bf_lo(w.w), bf_hi(w.w)}; }

__device__ __forceinline__ void load_rstd(const float* ssq, int rowbase, int fq, float (&rs)[2][4]) {
#pragma unroll
    for (int ai = 0; ai < 2; ++ai)
#pragma unroll
        for (int m = 0; m < 4; ++m) {
            const f32x4 v = *(const f32x4*)(ssq + (size_t)(rowbase + ai * HALF + m * 16) * 16 + fq * 4);
            float s = (v[0] + v[1]) + (v[2] + v[3]); s += __shfl_xor(s, 16); s += __shfl_xor(s, 32);
            rs[ai][m] = rsqrtf(s * (1.f / D) + EPS);
        }
}

struct EpiSwiglu {
    static constexpr bool PERM = true, SYNC = false; static constexpr int NST = 8;
    bf16_t* O; const float* ssq;
    __device__ __forceinline__ void operator()(f32x4 (&acc)[2][2][4][2], const Unit& u, int wr, int wc, int fr, int fq, LAS unsigned char*) const {
        const int row0 = u.pm * BM + wr * 64 + fr, col0 = u.pn * 128 + wc * 32 + 8 * fq;
        float rs[2][4]; load_rstd(ssq, row0, fq, rs);
#pragma unroll
        for (int ai = 0; ai < 2; ++ai)
#pragma unroll
            for (int m = 0; m < 4; ++m) {
                const f32x2 r2 = {rs[ai][m], rs[ai][m]};
                unsigned w[4];
#pragma unroll
                for (int q = 0; q < 4; ++q) {
                    const f32x4 ag = acc[ai][0][m][q >> 1], au = acc[ai][1][m][q >> 1];
                    const f32x2 g = (q & 1) ? (f32x2){ag[2], ag[3]} * r2 : (f32x2){ag[0], ag[1]} * r2;
                    const f32x2 up = (q & 1) ? (f32x2){au[2], au[3]} * r2 : (f32x2){au[0], au[1]} * r2;
                    const f32x2 t = g * (-1.4426950408889634f);
                    f32x2 d; d.x = __builtin_amdgcn_exp2f(t.x); d.y = __builtin_amdgcn_exp2f(t.y);
                    d = d + 1.0f;
                    f32x2 inv; inv.x = __builtin_amdgcn_rcpf(d.x); inv.y = __builtin_amdgcn_rcpf(d.y);
                    const f32x2 h = (g * up) * inv;
                    w[q] = cvt_pk_bf16(h.x, h.y);
                }
                __builtin_nontemporal_store((u32x4){w[0], w[1], w[2], w[3]}, (u32x4*)(O + (size_t)u.pm * BM * DFF + (size_t)(col0 >> 6) * (BM * BK) + (size_t)(wr * 64 + fr + ai * HALF + m * 16) * BK + (col0 & 63)));
                asm volatile("" ::: "memory");
            }
    }
};
struct EpiResid {
    static constexpr bool PERM = true, SYNC = false; static constexpr int NST = 16;
    bf16_t* xb; float* ssq; float alpha;
    __device__ __forceinline__ void operator()(f32x4 (&acc)[2][2][4][2], const Unit& u, int wr, int wc, int fr, int fq, LAS unsigned char*) const {
        const int row0 = u.pm * BM + wr * 64 + fr, col0 = u.pn * BM + wc * 32 + 8 * fq;
#pragma unroll
        for (int ai = 0; ai < 2; ++ai) {
            u32x4 xo[4][2];
#pragma unroll
            for (int m = 0; m < 4; ++m)
#pragma unroll
                for (int bj = 0; bj < 2; ++bj) xo[m][bj] = *(const u32x4*)(xb + (size_t)(row0 + ai * HALF + m * 16) * D + col0 + bj * HALF);
#pragma unroll
            for (int m = 0; m < 4; ++m) {
                const int row = row0 + ai * HALF + m * 16; float s = 0.f;
#pragma unroll
                for (int bj = 0; bj < 2; ++bj) {
                    f32x4 x0, x1; unpack8(xo[m][bj], x0, x1);
                    const u32x4 w = pack8(x0 + acc[ai][bj][m][0] * alpha, x1 + acc[ai][bj][m][1] * alpha);
                    *(u32x4*)(xb + (size_t)row * D + col0 + bj * HALF) = w;
                    unpack8(w, x0, x1);
                    s += ((x0[0] * x0[0] + x0[1] * x0[1]) + (x0[2] * x0[2] + x0[3] * x0[3])) + ((x1[0] * x1[0] + x1[1] * x1[1]) + (x1[2] * x1[2] + x1[3] * x1[3]));
                }
                s += __shfl_xor(s, 16); s += __shfl_xor(s, 32);
                if (fq == 0) ssq[(size_t)row * 16 + u.pn * 4 + wc] = s;
            }
            asm volatile("" ::: "memory");
        }
    }
};
struct EpiRowScale {
    static constexpr bool PERM = true, SYNC = false; static constexpr int NST = 16;
    bf16_t* O; int ldc; const float* ssq;
    __device__ __forceinline__ void operator()(f32x4 (&acc)[2][2][4][2], const Unit& u, int wr, int wc, int fr, int fq, LAS unsigned char*) const {
        const int row0 = u.pm * BM + wr * 64 + fr, col0 = u.pn * BM + wc * 32 + 8 * fq;
        float rs[2][4];
        if (ssq) load_rstd(ssq, row0, fq, rs);
        else {
#pragma unroll
            for (int ai = 0; ai < 2; ++ai)
#pragma unroll
                for (int m = 0; m < 4; ++m) rs[ai][m] = 1.f; }
#pragma unroll
        for (int ai = 0; ai < 2; ++ai)
#pragma unroll
            for (int m = 0; m < 4; ++m) { bf16_t* rowp = O + (size_t)(row0 + ai * HALF + m * 16) * ldc + col0;
#pragma unroll
                for (int bj = 0; bj < 2; ++bj) *(u32x4*)(rowp + bj * HALF) = pack8(acc[ai][bj][m][0] * rs[ai][m], acc[ai][bj][m][1] * rs[ai][m]);
                asm volatile("" ::: "memory"); }
    }
};
struct EpiWin {
    static constexpr bool PERM = true, SYNC = false; static constexpr int NST = 0;
    bf16_t* ucat; bf16_t* zpc; const float* ssq;
    __device__ __forceinline__ void operator()(f32x4 (&acc)[2][2][4][2], const Unit& u, int wr, int wc, int fr, int fq, LAS unsigned char*) const {
        const int row0 = u.pm * BM + wr * 64 + fr, col0 = u.pn * BM + wc * 32 + 8 * fq;
        float rs[2][4]; load_rstd(ssq, row0, fq, rs);
#pragma unroll
        for (int ai = 0; ai < 2; ++ai)
#pragma unroll
            for (int m = 0; m < 4; ++m) { const int row = row0 + ai * HALF + m * 16;
#pragma unroll
                for (int bj = 0; bj < 2; ++bj) {
                    const int col = col0 + bj * HALF;
                    const u32x4 w = pack8(acc[ai][bj][m][0] * rs[ai][m], acc[ai][bj][m][1] * rs[ai][m]);
                    if (col < DSSM) { const int g = col >> 4, i0 = col & 15; *(u32x4*)(ucat + ((size_t)(g * NCH + row / CH) * KCAT + 128 + (row % CH) * 16 + i0)) = w; }
                    else if (col < DIN) *(u32x4*)(zpc + (size_t)row * D + (col - DSSM)) = w;
                }
                asm volatile("" ::: "memory"); }
    }
};
struct EpiKV {
    static constexpr bool PERM = true, SYNC = false; static constexpr int NST = 0;
    bf16_t* kb; bf16_t* vt; const float* rsmem;
    __device__ __forceinline__ void operator()(f32x4 (&acc)[2][2][4][2], const Unit& u, int wr, int wc, int fr, int fq, LAS unsigned char*) const {
        const int row0 = u.pm * BM + wr * 64 + fr, col0 = u.pn * BM + wc * 32 + 8 * fq, l = u.kind >> 1;
        if ((u.kind & 1) == 0) {
            bf16_t* O = kb + (size_t)l * MM * D;
#pragma unroll
            for (int ai = 0; ai < 2; ++ai)
#pragma unroll
                for (int m = 0; m < 4; ++m) { const int row = row0 + ai * HALF + m * 16; const float r = rsmem[row];
#pragma unroll
                    for (int bj = 0; bj < 2; ++bj) *(u32x4*)(O + (size_t)row * D + col0 + bj * HALF) = pack8(acc[ai][bj][m][0] * r, acc[ai][bj][m][1] * r);
                    asm volatile("" ::: "memory"); }
        } else {
            bf16_t* O = vt + (size_t)l * MM * D;
            f32x4 cs[2][2];
#pragma unroll
            for (int bj = 0; bj < 2; ++bj)
#pragma unroll
                for (int n = 0; n < 2; ++n) cs[bj][n] = *(const f32x4*)(rsmem + col0 + bj * HALF + 4 * n);
#pragma unroll
            for (int ai = 0; ai < 2; ++ai)
#pragma unroll
                for (int m = 0; m < 4; ++m) { const int row = row0 + ai * HALF + m * 16;
#pragma unroll
                    for (int bj = 0; bj < 2; ++bj) *(u32x4*)(O + (size_t)row * MM + col0 + bj * HALF) = pack8(acc[ai][bj][m][0] * cs[bj][0], acc[ai][bj][m][1] * cs[bj][1]);
                    asm volatile("" ::: "memory"); }
        }
    }
};
struct EpiXloc {
    static constexpr bool PERM = false, SYNC = false; static constexpr int NST = 0;
    float* xloc;
    __device__ __forceinline__ void operator()(f32x4 (&acc)[2][2][4][2], const Unit& u, int wr, int wc, int fr, int fq, LAS unsigned char*) const {
        const int row0 = u.pm * BM + wr * 64 + fr, col0 = wc * 32 + 4 * fq;
#pragma unroll
        for (int ai = 0; ai < 2; ++ai)
#pragma unroll
            for (int m = 0; m < 4; ++m)
#pragma unroll
                for (int n = 0; n < 2; ++n) *(f32x4*)(xloc + (size_t)(row0 + ai * HALF + m * 16) * 128 + col0 + n * 16) = acc[ai][0][m][n];
    }
};
struct EpiS5 {
    static constexpr bool PERM = true, SYNC = false; static constexpr int NST = 16;
    const bf16_t* ucat; bf16_t* yg; const float* dvec;
    __device__ __forceinline__ void operator()(f32x4 (&acc)[2][2][4][2], const Unit& u, int wr, int wc, int fr, int fq, LAS unsigned char*) const {
        const int row0 = u.pm * BM + wr * 64 + fr, col0 = u.pn * BM + wc * 32 + 8 * fq, g = u.pm / (NCH / BM);
        const int o0 = col0 & 15;
        const f32x4 d0 = *(const f32x4*)(dvec + g * SG + o0), d1 = *(const f32x4*)(dvec + g * SG + o0 + 4);
#pragma unroll
        for (int ai = 0; ai < 2; ++ai) {
            u32x4 uv[4][2];
#pragma unroll
            for (int m = 0; m < 4; ++m)
#pragma unroll
                for (int bj = 0; bj < 2; ++bj) uv[m][bj] = *(const u32x4*)(ucat + (size_t)(row0 + ai * HALF + m * 16) * KCAT + 128 + col0 + bj * HALF);
#pragma unroll
            for (int m = 0; m < 4; ++m) { const int row = row0 + ai * HALF + m * 16, chunk = row & (NCH - 1);
#pragma unroll
                for (int bj = 0; bj < 2; ++bj) {
                    const int col = col0 + bj * HALF, t = col >> 4;
                    f32x4 u0, u1; unpack8(uv[m][bj], u0, u1);
                    f32x4 y0 = acc[ai][bj][m][0] + d0 * u0, y1 = acc[ai][bj][m][1] + d1 * u1;
#pragma unroll
                    for (int e = 0; e < 4; ++e) { y0[e] = gelu_tanh(y0[e]); y1[e] = gelu_tanh(y1[e]); }
                    *(u32x4*)(yg + (size_t)(chunk * CH + t) * DSSM + g * SG + o0) = pack8(y0, y1);
                } }
            asm volatile("" ::: "memory");
        }
    }
};
struct EpiGlu {
    static constexpr bool PERM = true, SYNC = false; static constexpr int NST = 0;
    const bf16_t* yg; bf16_t* ymix;
    __device__ __forceinline__ void operator()(f32x4 (&acc)[2][2][4][2], const Unit& u, int wr, int wc, int fr, int fq, LAS unsigned char*) const {
        const int row0 = u.pm * BM + wr * 64 + fr, col0 = u.pn * BM + wc * 32 + 8 * fq;
#pragma unroll
        for (int ai = 0; ai < 2; ++ai) {
            u32x4 yv[4][2];
#pragma unroll
            for (int m = 0; m < 4; ++m)
#pragma unroll
                for (int bj = 0; bj < 2; ++bj) { const int col = col0 + bj * HALF; yv[m][bj] = (col < DSSM) ? *(const u32x4*)(yg + (size_t)(row0 + ai * HALF + m * 16) * DSSM + col) : (u32x4){0u, 0u, 0u, 0u}; }
#pragma unroll
            for (int m = 0; m < 4; ++m) { const int row = row0 + ai * HALF + m * 16;
#pragma unroll
                for (int bj = 0; bj < 2; ++bj) {
                    const int col = col0 + bj * HALF;
                    if (col < DSSM) {
                        f32x4 y0, y1; unpack8(yv[m][bj], y0, y1);
                        f32x4 a = acc[ai][bj][m][0], b = acc[ai][bj][m][1];
#pragma unroll
                        for (int e = 0; e < 4; ++e) { a[e] = y0[e] * fsigm(a[e]); b[e] = y1[e] * fsigm(b[e]); }
                        *(u32x4*)(ymix + (size_t)row * D + col) = pack8(a, b);
                    } } }
            asm volatile("" ::: "memory");
        }
    }
};
struct EpiSoftmax {
    static constexpr bool PERM = true, SYNC = true; static constexpr int NST = 16;
    bf16_t* O;
    __device__ __forceinline__ void operator()(f32x4 (&acc)[2][2][4][2], const Unit& u, int wr, int wc, int fr, int fq, LAS unsigned char* xch) const {
        LAS float* Lmax = (LAS float*)xch; LAS float* Lsum = Lmax + 1024;
        const float sc = 0.0625f * 1.4426950408889634f;
#pragma unroll
        for (int ai = 0; ai < 2; ++ai)
#pragma unroll
            for (int m = 0; m < 4; ++m) {
                float mx = -3.0e38f;
#pragma unroll
                for (int bj = 0; bj < 2; ++bj)
#pragma unroll
                    for (int n = 0; n < 2; ++n) { acc[ai][bj][m][n] = acc[ai][bj][m][n] * sc; const f32x4 v = acc[ai][bj][m][n]; mx = fmaxf(mx, fmaxf(fmaxf(v[0], v[1]), fmaxf(v[2], v[3]))); }
                mx = fmaxf(mx, __shfl_xor(mx, 16)); mx = fmaxf(mx, __shfl_xor(mx, 32));
                if (fq == 0) Lmax[(ai * HALF + wr * 64 + m * 16 + fr) * 4 + wc] = mx;
                asm volatile("" ::: "memory");
            }
        asm volatile("s_waitcnt lgkmcnt(0)" ::: "memory"); __builtin_amdgcn_s_barrier(); asm volatile("" ::: "memory");
#pragma unroll
        for (int ai = 0; ai < 2; ++ai)
#pragma unroll
            for (int m = 0; m < 4; ++m) {
                const f32x4 mv = *(const LAS f32x4*)(Lmax + (ai * HALF + wr * 64 + m * 16 + fr) * 4);
                const float mx = fmaxf(fmaxf(mv[0], mv[1]), fmaxf(mv[2], mv[3])); float s = 0.f;
#pragma unroll
                for (int bj = 0; bj < 2; ++bj)
#pragma unroll
                    for (int n = 0; n < 2; ++n) { f32x4 v = acc[ai][bj][m][n];
#pragma unroll
                        for (int e = 0; e < 4; ++e) { v[e] = __builtin_amdgcn_exp2f(v[e] - mx); s += v[e]; }
                        acc[ai][bj][m][n] = v; }
                s += __shfl_xor(s, 16); s += __shfl_xor(s, 32);
                if (fq == 0) Lsum[(ai * HALF + wr * 64 + m * 16 + fr) * 4 + wc] = s;
                asm volatile("" ::: "memory");
            }
        asm volatile("s_waitcnt lgkmcnt(0)" ::: "memory"); __builtin_amdgcn_s_barrier(); asm volatile("" ::: "memory");
        const int row0 = u.pm * BM + wr * 64 + fr, col0 = u.pn * BM + wc * 32 + 8 * fq;
#pragma unroll
        for (int ai = 0; ai < 2; ++ai)
#pragma unroll
            for (int m = 0; m < 4; ++m) {
                const f32x4 sv = *(const LAS f32x4*)(Lsum + (ai * HALF + wr * 64 + m * 16 + fr) * 4);
                const float inv = 1.f / ((sv[0] + sv[1]) + (sv[2] + sv[3]));
                bf16_t* rowp = O + (size_t)(row0 + ai * HALF + m * 16) * D + col0;
#pragma unroll
                for (int bj = 0; bj < 2; ++bj) *(u32x4*)(rowp + bj * HALF) = pack8(acc[ai][bj][m][0] * inv, acc[ai][bj][m][1] * inv);
                asm volatile("" ::: "memory");
            }
    }
};

template <class Epi, class SchedT>
__device__ __forceinline__ void gemm_phase(LAS unsigned char* lds, const Gemm g, const SchedT& S, const Epi& E) {
    int tid_ = threadIdx.x; asm volatile("" : "+v"(tid_));
    const int tid = tid_, wid = __builtin_amdgcn_readfirstlane(tid >> 6), lane = tid & 63, wr = wid >> 2, wc = wid & 3, fr = lane & 15, fq = lane >> 4;
    int nt_ = g.K / BK; asm volatile("" : "+s"(nt_)); const int ntK = nt_;
    unsigned voffA[2], voffB[2];
#pragma unroll
    for (int i = 0; i < 2; ++i) { int R, C; stage_rc(tid * 16 + i * 8192, R, C); const int Rb = Epi::PERM ? ((R & ~31) + perm32(R & 31)) : R;
        voffA[i] = g.a_blocked ? (unsigned)(R * BK + C) * 2u : (unsigned)(R * g.lda + C) * 2u; voffB[i] = g.b_blocked ? (unsigned)(Rb * BK + C) * 2u : (unsigned)(Rb * g.ldb + C) * 2u; }
    const size_t kstep = (size_t)(BK * 2), kstepA = g.a_blocked ? (size_t)(BM * BK * 2) : kstep, kstepB = g.b_blocked ? (size_t)(BM * BK * 2) : kstep;
    const size_t hstepA = g.a_blocked ? (size_t)(HALF * BK * 2) : (size_t)HALF * g.lda * 2, hstepB = g.b_blocked ? (size_t)(HALF * BK * 2) : (size_t)HALF * g.ldb * 2;
    const unsigned ldsw = (unsigned)wid * 1024u;
    const int aoff = lds_byte(wr * 64 + fr, fq * 8), boff = lds_byte(wc * 32 + fr, fq * 8);
#define PG8_SA(b, h) (((b) * 2 + (h)) * HTB)
#define PG8_SB(b, h) ((4 + (b) * 2 + (h)) * HTB)
#define PG8_STAGE(bufoff, gbase, voff) do { _Pragma("unroll") for (int _i = 0; _i < 2; ++_i) \
        __builtin_amdgcn_global_load_lds((const unsigned*)((const char*)(gbase) + (voff)[_i]), (LAS unsigned*)(lds + (bufoff) + ldsw + _i * 8192), 16, 0, 0); } while (0)
#define PG8_LDA(dst, b, h) do { _Pragma("unroll") for (int m = 0; m < 4; ++m) _Pragma("unroll") for (int k = 0; k < 2; ++k) dst[m][k] = *(const LAS bf16x8*)(lds + PG8_SA(b, h) + aoff + m * 2048 + k * 1024); } while (0)
#define PG8_LDB(dst, b, h) do { _Pragma("unroll") for (int n = 0; n < 2; ++n) _Pragma("unroll") for (int k = 0; k < 2; ++k) dst[n][k] = *(const LAS bf16x8*)(lds + PG8_SB(b, h) + boff + n * 2048 + k * 1024); } while (0)
#define PG8_MMA(ai, bj, At, Bt) do { __builtin_amdgcn_s_setprio(1); _Pragma("unroll") for (int m = 0; m < 4; ++m) _Pragma("unroll") for (int n = 0; n < 2; ++n) _Pragma("unroll") for (int k = 0; k < 2; ++k) \
        acc[ai][bj][m][n] = __builtin_amdgcn_mfma_f32_16x16x32_bf16(Bt[n][k], At[m][k], acc[ai][bj][m][n], 0, 0, 0); __builtin_amdgcn_s_setprio(0); } while (0)
#define PG8_WAIT_V(n) asm volatile("s_waitcnt vmcnt(" #n ")" ::: "memory")
#define PG8_WAIT_L(n) asm volatile("s_waitcnt lgkmcnt(" #n ")" ::: "memory")
#define PG8_BAR __builtin_amdgcn_s_barrier()
#define PG8_SCHED __builtin_amdgcn_sched_barrier(0)
    Unit cur, nxt; int ui = 0;
    if (!S.next(0, cur)) return;
    f32x4 acc[2][2][4][2];
#pragma unroll
    for (int a = 0; a < 2; ++a)
#pragma unroll
        for (int b = 0; b < 2; ++b)
#pragma unroll
            for (int m = 0; m < 4; ++m)
#pragma unroll
                for (int n = 0; n < 2; ++n) acc[a][b][m][n] = (f32x4){0.f, 0.f, 0.f, 0.f};
    bf16x8 At[4][2], B0[2][2], B1[2][2];
    const char* cA = (const char*)g.A + cur.aoff; const char* cB = (const char*)g.Bt + cur.boff;
    PG8_STAGE(PG8_SB(0, 0), cB, voffB); PG8_STAGE(PG8_SB(0, 1), cB + hstepB, voffB); PG8_STAGE(PG8_SA(0, 0), cA, voffA); PG8_STAGE(PG8_SA(0, 1), cA + hstepA, voffA);
    if (wr == 1) PG8_BAR;
    PG8_WAIT_V(2); PG8_BAR;
    PG8_STAGE(PG8_SB(1, 0), cB + kstepB, voffB); PG8_STAGE(PG8_SA(1, 0), cA + kstepA, voffA); PG8_STAGE(PG8_SB(1, 1), cB + hstepB + kstepB, voffB);
    PG8_WAIT_V(6); PG8_BAR;
    for (;;) {
        const int nt = cur.nt ? cur.nt : ntK;
        const bool has_next = S.next(ui + 1, nxt);
        const char* nA = has_next ? (const char*)g.A + nxt.aoff : cA; const char* nB = has_next ? (const char*)g.Bt + nxt.boff : cB;
        for (int t = 0; t < nt; t += 2) {
            const bool last = (t == nt - 2);
            const char* a1 = cA + (size_t)(t + 1) * kstepA;
            const char* a2 = last ? nA : cA + (size_t)(t + 2) * kstepA; const char* b2 = last ? nB : cB + (size_t)(t + 2) * kstepB;
            const char* a3 = a2 + kstepA; const char* b3 = b2 + kstepB;
            PG8_LDB(B0, 0, 0); PG8_LDB(B1, 0, 1); PG8_SCHED; PG8_LDA(At, 0, 0); PG8_STAGE(PG8_SA(1, 1), a1 + hstepA, voffA);
            PG8_WAIT_V(8); PG8_WAIT_L(0); PG8_BAR; PG8_MMA(0, 0, At, B0); PG8_MMA(0, 1, At, B1); PG8_BAR; PG8_SCHED;
            PG8_LDA(At, 0, 1); PG8_STAGE(PG8_SB(0, 0), b2, voffB); PG8_STAGE(PG8_SB(0, 1), b2 + hstepB, voffB); PG8_STAGE(PG8_SA(0, 0), a2, voffA);
            PG8_WAIT_V(8); PG8_WAIT_L(0); PG8_BAR; PG8_MMA(1, 0, At, B0); PG8_MMA(1, 1, At, B1); PG8_BAR; PG8_SCHED;
            PG8_LDB(B0, 1, 0); PG8_LDB(B1, 1, 1); PG8_SCHED; PG8_LDA(At, 1, 0); PG8_STAGE(PG8_SA(0, 1), a2 + hstepA, voffA);
            PG8_WAIT_V(8); PG8_WAIT_L(0); PG8_BAR; PG8_MMA(0, 0, At, B0); PG8_MMA(0, 1, At, B1); PG8_BAR; PG8_SCHED;
            PG8_LDA(At, 1, 1); PG8_STAGE(PG8_SB(1, 0), b3, voffB); PG8_STAGE(PG8_SB(1, 1), b3 + hstepB, voffB); PG8_STAGE(PG8_SA(1, 0), a3, voffA);
            PG8_WAIT_V(8); PG8_WAIT_L(0); PG8_BAR; PG8_MMA(1, 0, At, B0); PG8_MMA(1, 1, At, B1); PG8_BAR; PG8_SCHED;
        }
        if (wr == 0) PG8_BAR;
        E(acc, cur, wr, wc, fr, fq, lds + XCH_OFF);
        if (!has_next) break;
#pragma unroll
        for (int a = 0; a < 2; ++a)
#pragma unroll
            for (int b = 0; b < 2; ++b)
#pragma unroll
                for (int m = 0; m < 4; ++m)
#pragma unroll
                    for (int n = 0; n < 2; ++n) acc[a][b][m][n] = (f32x4){0.f, 0.f, 0.f, 0.f};
        cur = nxt; cA = nA; cB = nB; ++ui;
        if (wr == 1) PG8_BAR;
    }
    PG8_WAIT_V(0);
    PG8_BAR;
#undef PG8_SA
#undef PG8_SB
#undef PG8_STAGE
#undef PG8_LDA
#undef PG8_LDB
#undef PG8_MMA
#undef PG8_WAIT_V
#undef PG8_WAIT_L
#undef PG8_BAR
#undef PG8_SCHED
}
#define XB_TMO      128
#define XB_XCNT(j)  (256  + 64 * (j))
#define XB_XSUB(j)  (1280 + 64 * (j))
#define XB_XGEN(j)  (2304 + 64 * (j))
#define XB_TOP      3328
#define XB_TOPGEN   3392
#define XCD_BAR_WORDS 3456
#define XB_SPIN_CAP (1u << 20)
__device__ __forceinline__ unsigned xb_ld(unsigned* p)              { return __hip_atomic_load(p, __ATOMIC_RELAXED, __HIP_MEMORY_SCOPE_AGENT); }
__device__ __forceinline__ unsigned xb_add(unsigned* p, unsigned v) { return __hip_atomic_fetch_add(p, v, __ATOMIC_RELAXED, __HIP_MEMORY_SCOPE_AGENT); }
__device__ __forceinline__ unsigned xb_xcc_id() { return (unsigned)__builtin_amdgcn_s_getreg((3 << 11) | 20) & 0xFu; }
#define XB_SPIN(cond, bar) do { unsigned _sp = 0; while (cond) { __builtin_amdgcn_s_sleep(1); \
    if ((++_sp & 255u) == 0u) { if (xb_ld(&(bar)[XB_TMO])) break; if (_sp > XB_SPIN_CAP) { atomicAdd(&(bar)[XB_TMO], 1u); break; } } } } while (0)
struct XcdBarrier { unsigned* bar; unsigned x; volatile LAS unsigned* st; };
__device__ __forceinline__ XcdBarrier xcd_barrier_post(unsigned* bar, volatile LAS unsigned* st) {
    XcdBarrier b; b.bar = bar; b.x = xb_xcc_id(); b.st = st;
    if (threadIdx.x == 0) (void)xb_add(&bar[XB_XCNT(b.x)], 1u);
    return b;
}
__device__ __forceinline__ void xcd_barrier_complete(unsigned* bar, unsigned x, unsigned& nloc, unsigned& nx) {
    const unsigned G = gridDim.x * gridDim.y * gridDim.z;
    unsigned sum, cnt, mine, sp = 0u;
    for (;;) {
        sum = 0u; cnt = 0u; mine = 0u;
#pragma unroll
        for (unsigned j = 0; j < 16; ++j) { const unsigned c = xb_ld(&bar[XB_XCNT(j)]); sum += c; cnt += (c > 0u) ? 1u : 0u; mine = (j == x) ? c : mine; }
        if (sum == G) break;
        __builtin_amdgcn_s_sleep(1);
        if ((++sp & 255u) == 0u) { if (xb_ld(&bar[XB_TMO])) break; if (sp > XB_SPIN_CAP) { atomicAdd(&bar[XB_TMO], 1u); break; } }
    }
    nloc = mine > 0u ? mine : 1u; nx = cnt > 0u ? cnt : 1u;
}
__device__ __forceinline__ void xcd_barrier(const XcdBarrier& b) {
    asm volatile("s_waitcnt vmcnt(0)" ::: "memory");
    __syncthreads();
    if (threadIdx.x == 0) {
        unsigned* bar = b.bar;
        __builtin_amdgcn_s_waitcnt(0);
        unsigned nloc = b.st[0], nx = b.st[1];
        if (nloc == 0u) { xcd_barrier_complete(bar, b.x, nloc, nx); b.st[0] = nloc; b.st[1] = nx; }
        const unsigned old = xb_add(&bar[XB_XSUB(b.x)], 1u);
        const unsigned gen = old / nloc;
        if (old + 1u == (gen + 1u) * nloc) {
            __builtin_amdgcn_fence(__ATOMIC_RELEASE, "agent");
            asm volatile("s_waitcnt vmcnt(0)" ::: "memory");
            const unsigned og = xb_add(&bar[XB_TOP], 1u);
            const unsigned tg = og / nx;
            if (og + 1u == (tg + 1u) * nx) xb_add(&bar[XB_TOPGEN], 1u);
            else XB_SPIN(xb_ld(&bar[XB_TOPGEN]) == tg, bar);
            __builtin_amdgcn_fence(__ATOMIC_ACQUIRE, "agent");
            xb_add(&bar[XB_XGEN(b.x)], 1u);
            asm volatile("s_waitcnt vmcnt(0)" ::: "memory");
        } else {
            XB_SPIN(xb_ld(&bar[XB_XGEN(b.x)]) == gen, bar);
            __builtin_amdgcn_fence(__ATOMIC_ACQUIRE, "agent");
            asm volatile("s_waitcnt vmcnt(0)" ::: "memory");
        }
    }
    __syncthreads();
}

__device__ __forceinline__ float wave_sum(float v) {
#pragma unroll
    for (int o = 1; o < 64; o <<= 1) v += __shfl_xor(v, o);
    return v;
}
#define LDS_WAIT() asm volatile("s_waitcnt lgkmcnt(0)" ::: "memory")
__device__ __forceinline__ void lam_pow(float lr, float li, float dt, float k, float& pr, float& pi) {
    const float mag = __expf(lr * dt * k);
    const float rev = __builtin_amdgcn_fractf(li * dt * 0.15915494309189535f * k);
    pr = mag * __builtin_amdgcn_cosf(rev); pi = mag * __builtin_amdgcn_sinf(rev);
}
__device__ __forceinline__ void zcoef(float lr, float li, float dt, float& zr, float& zi) {
    const float mag = expf(lr * dt), ar = mag * cosf(li * dt), ai = mag * sinf(li * dt), den = lr * lr + li * li;
    zr = ((ar - 1.f) * lr + ai * li) / den; zi = (ai * lr - (ar - 1.f) * li) / den;
}

struct Args { const float* in[35]; float* out; unsigned char* ws; int ph_lo, ph_hi; };
typedef const Args __attribute__((address_space(4)))* KArgs;
__device__ __forceinline__ KArgs kargs() { unsigned long v = (unsigned long)__builtin_amdgcn_kernarg_segment_ptr(); asm volatile("" : "+s"(v)); return (KArgs)v; }
enum { I_X = 0, I_MEM, I_F1N, I_F1G, I_F1U, I_F1D, I_MIXN, I_WIN, I_WOUT, I_LRE, I_LIM, I_LDT, I_BRE, I_BIM, I_CRE, I_CIM, I_SD, I_WGLU, I_PW, I_PS, I_CW, I_CB, I_LNG, I_LNB,
       I_XN, I_MN, I_WQ, I_WK, I_WV, I_WO, I_F2N, I_F2G, I_F2U, I_F2D, I_FN };

__device__ __forceinline__ void tr_load(const float* W, int ldw, const float* gain, int k0, int n0, int lane, float (&v)[32]) {
#pragma unroll
    for (int i = 0; i < 32; ++i) { const int kk = 2 * i + (lane >> 5); v[i] = __builtin_nontemporal_load(W + (size_t)(k0 + kk) * ldw + n0 + (lane & 31)); }
    if (gain) {
#pragma unroll
        for (int i = 0; i < 32; ++i) v[i] *= gain[k0 + 2 * i + (lane >> 5)]; }
}
__device__ __forceinline__ void tr_store(const float (&v)[32], bf16_t* WT, int ldt, int k0, int drow0, LAS float* scr, int lane, int blk) {
#pragma unroll
    for (int i = 0; i < 32; ++i) scr[(2 * i + (lane >> 5)) * 33 + (lane & 31)] = v[i];
    LDS_WAIT(); asm volatile("" ::: "memory");
    const int c = lane & 7;
#pragma unroll
    for (int j = 0; j < 4; ++j) { const int n = (lane >> 3) + 8 * j; const LAS float* s = scr + (8 * c) * 33 + n;
        u32x4 o; o.x = cvt_pk_bf16(s[0 * 33], s[1 * 33]); o.y = cvt_pk_bf16(s[2 * 33], s[3 * 33]); o.z = cvt_pk_bf16(s[4 * 33], s[5 * 33]); o.w = cvt_pk_bf16(s[6 * 33], s[7 * 33]);
        const int dr = drow0 + n;
        bf16_t* dst = blk ? WT + (size_t)(dr >> 8) * 256 * ldt + (size_t)(k0 >> 6) * (256 * 64) + (dr & 255) * 64 + 8 * c
                          : WT + (size_t)dr * ldt + k0 + 8 * c;
        *(u32x4*)dst = o; }
    LDS_WAIT(); asm volatile("" ::: "memory");
}
__device__ __forceinline__ void tr_matrix(int& base, int gw, int NGW, const float* W, int K, int N, int ldw, const float* gain, bf16_t* WT, int ldt, int grp, int gstride, int goff,
                                          int skip_lo, int skip_hi, LAS float* scr, int lane, int blk = 0) {
    const int nblk = N / 32, nkb = K / 64 - (skip_hi - skip_lo), cnt = nkb * nblk;
    int first = (gw - base) % NGW; if (first < 0) first += NGW;
    float va[32], vb[32];
    int it = first;
#define TR_DECODE(IT, K0, N0) int K0, N0; { int kb = (IT) / nblk; const int nb = (IT) % nblk; if (kb >= skip_lo) kb += skip_hi - skip_lo; K0 = kb * 64; N0 = nb * 32; }
    if (it < cnt) { TR_DECODE(it, k0, n0); tr_load(W, ldw, gain, k0, n0, lane, va); }
    while (it < cnt) {
        TR_DECODE(it, k0, n0);
        const int it2 = it + NGW;
        if (it2 < cnt) { TR_DECODE(it2, k2, n2); tr_load(W, ldw, gain, k2, n2, lane, vb); }
        tr_store(va, WT, ldt, k0, (n0 / grp) * gstride + goff + (n0 % grp), scr, lane, blk);
        it = it2;
        if (it >= cnt) break;
        { TR_DECODE(it, k1, n1);
          const int it3 = it + NGW;
          if (it3 < cnt) { TR_DECODE(it3, k3, n3); tr_load(W, ldw, gain, k3, n3, lane, va); }
          tr_store(vb, WT, ldt, k1, (n1 / grp) * gstride + goff + (n1 % grp), scr, lane, blk);
          it = it3; }
    }
#undef TR_DECODE
    base = (base + cnt) % NGW;
}

__device__ __forceinline__ void p0a(LAS unsigned char* lds, int tid, int lane, int wave, int bid, int G) {
    KArgs a = kargs();
    unsigned char* ws = a->ws;
    LAS float* scr = (LAS float*)(lds + wave * 16384);
    const int gw = bid * 8 + wave, NGW = G * 8;
    int base = 0;
    for (int l = 0; l < ((REP_MASK >> 16) & 1 ? 4 : 2); ++l) {
        unsigned char* wl = ws + WS_WL + (size_t)(l & 1) * WL_STRIDE;
        const int BIG = 1 << 30;
        tr_matrix(base, gw, NGW, a->in[I_F1G] + (size_t)(l & 1) * D * DFF, D, DFF, DFF, a->in[I_F1N] + (l & 1) * D, (bf16_t*)(wl + WL_GU1), D, 128, 256, 0, 0, 0, scr, lane);
        tr_matrix(base, gw, NGW, a->in[I_F1U] + (size_t)(l & 1) * D * DFF, D, DFF, DFF, a->in[I_F1N] + (l & 1) * D, (bf16_t*)(wl + WL_GU1), D, 128, 256, 128, 0, 0, scr, lane);
        tr_matrix(base, gw, NGW, a->in[I_F1D] + (size_t)(l & 1) * DFF * D, DFF, D, D, nullptr, (bf16_t*)(wl + WL_D1), DFF, BIG, 0, 0, 0, 0, scr, lane, 1);
        tr_matrix(base, gw, NGW, a->in[I_F2G] + (size_t)(l & 1) * D * DFF, D, DFF, DFF, a->in[I_F2N] + (l & 1) * D, (bf16_t*)(wl + WL_GU2), D, 128, 256, 0, 0, 0, scr, lane);
        tr_matrix(base, gw, NGW, a->in[I_F2U] + (size_t)(l & 1) * D * DFF, D, DFF, DFF, a->in[I_F2N] + (l & 1) * D, (bf16_t*)(wl + WL_GU2), D, 128, 256, 128, 0, 0, scr, lane);
        tr_matrix(base, gw, NGW, a->in[I_F2D] + (size_t)(l & 1) * DFF * D, DFF, D, D, nullptr, (bf16_t*)(wl + WL_D2), DFF, BIG, 0, 0, 0, 0, scr, lane, 1);
        tr_matrix(base, gw, NGW, a->in[I_WIN] + (size_t)(l & 1) * D * DIN, D, DIN, DIN, a->in[I_MIXN] + (l & 1) * D, (bf16_t*)(wl + WL_IN), D, BIG, 0, 0, 0, 0, scr, lane);
        tr_matrix(base, gw, NGW, a->in[I_WOUT] + (size_t)(l & 1) * D * D, D, D, D, nullptr, (bf16_t*)(wl + WL_OUT), D, BIG, 0, 0, 6, 10, scr, lane);
        tr_matrix(base, gw, NGW, a->in[I_WQ] + (size_t)(l & 1) * D * D, D, D, D, a->in[I_XN] + (l & 1) * D, (bf16_t*)(wl + WL_Q), D, BIG, 0, 0, 0, 0, scr, lane);
        tr_matrix(base, gw, NGW, a->in[I_WK] + (size_t)(l & 1) * D * D, D, D, D, a->in[I_MN] + (l & 1) * D, (bf16_t*)(wl + WL_K), D, BIG, 0, 0, 0, 0, scr, lane);
        tr_matrix(base, gw, NGW, a->in[I_WV] + (size_t)(l & 1) * D * D, D, D, D, a->in[I_MN] + (l & 1) * D, (bf16_t*)(wl + WL_V), D, BIG, 0, 0, 0, 0, scr, lane);
        tr_matrix(base, gw, NGW, a->in[I_WO] + (size_t)(l & 1) * D * D, D, D, D, nullptr, (bf16_t*)(wl + WL_O), D, BIG, 0, 0, 0, 0, scr, lane);
        tr_matrix(base, gw, NGW, a->in[I_WGLU] + (size_t)(l & 1) * DSSM * DSSM, DSSM, DSSM, DSSM, nullptr, (bf16_t*)(wl + WL_GLU), DSSM, BIG, 0, 0, 0, 0, scr, lane);
    }
    const int gt = bid * 512 + tid, NGT = G * 512;
    for (int _r = 0; _r < ((REP_MASK >> 17) & 1 ? 2 : 1); ++_r)
    for (int it = gt; it < 2 * DPOOL * D; it += NGT) {
        const int n = it & (D - 1), c = (it >> 10) & (DPOOL - 1), l = it >> 18, g = c >> 6;
        const float* pw = a->in[I_PW] + ((size_t)(l * 4 + g) * 64 + (c & 63)) * 64; const float* ps = a->in[I_PS] + l * DPOOL + g * 64;
        const float* wo = a->in[I_WOUT] + (size_t)l * D * D + (size_t)(DSSM + g * 64) * D + n;
        float s = 0.f;
#pragma unroll 8
        for (int d = 0; d < 64; ++d) s += pw[d] * ps[d] * wo[(size_t)d * D];
        ((bf16_t*)(ws + WS_WL + (size_t)l * WL_STRIDE + WL_OUT))[(size_t)n * D + DSSM + c] = (bf16_t)(cvt_pk_bf16(s, 0.f) & 0xffffu);
    }
    for (int _r = 0; _r < ((REP_MASK >> 17) & 1 ? 2 : 1); ++_r)
    for (int it = gt; it < 2 * NGR * 128 * (NTOK / 8); it += NGT) {
        const int k8 = it % (NTOK / 8), r = (it / (NTOK / 8)) & 127, gl = it / (128 * (NTOK / 8)), g = gl % NGR, l = gl / NGR, p = r & 63, s = k8 >> 1, i0 = (k8 & 1) * 8;
        const float lr = a->in[I_LRE][(l * NGR + g) * NP + p], li = a->in[I_LIM][(l * NGR + g) * NP + p], dt = expf(a->in[I_LDT][l * NGR + g]);
        float zr, zi, pr, pi; zcoef(lr, li, dt, zr, zi); lam_pow(lr, li, dt, (float)(CH - 1 - s), pr, pi);
        const float wr_ = pr * zr - pi * zi, wi_ = pr * zi + pi * zr;
        const float* br = a->in[I_BRE] + ((size_t)(l * NGR + g) * NP + p) * SG + i0; const float* bi = a->in[I_BIM] + ((size_t)(l * NGR + g) * NP + p) * SG + i0;
        float v[8];
#pragma unroll
        for (int e = 0; e < 8; ++e) v[e] = (r < 64) ? (wr_ * br[e] - wi_ * bi[e]) : (wr_ * bi[e] + wi_ * br[e]);
        u32x4 o; o.x = cvt_pk_bf16(v[0], v[1]); o.y = cvt_pk_bf16(v[2], v[3]); o.z = cvt_pk_bf16(v[4], v[5]); o.w = cvt_pk_bf16(v[6], v[7]);
        *(u32x4*)((bf16_t*)(ws + WS_WL + (size_t)l * WL_STRIDE + WL_GM) + ((size_t)(g * 128 + r) * NTOK + k8 * 8)) = o;
    }
    for (int row = gw; row < M + MM; row += 2 * NGW) {
        const int row2 = row + NGW; const bool has2 = row2 < M + MM;
        f32x4 v[2][4];
#pragma unroll
        for (int q = 0; q < 2; ++q) { const int rr = q ? row2 : row; if (q && !has2) break; const bool isx = rr < M; const int r = isx ? rr : rr - M;
            const f32x4* src = (const f32x4*)((isx ? a->in[I_X] : a->in[I_MEM]) + (size_t)r * D);
#pragma unroll
            for (int j = 0; j < 4; ++j) v[q][j] = __builtin_nontemporal_load(src + lane + 64 * j); }
#pragma unroll
        for (int q = 0; q < 2; ++q) { const int rr = q ? row2 : row; if (q && !has2) break; const bool isx = rr < M; const int r = isx ? rr : rr - M;
            bf16_t* dst = (bf16_t*)(ws + (isx ? WS_XB : WS_MEMB)) + (size_t)r * D;
            float s = 0.f;
#pragma unroll
            for (int j = 0; j < 4; ++j) { const f32x4 x = v[q][j]; s += (x[0] * x[0] + x[1] * x[1]) + (x[2] * x[2] + x[3] * x[3]);
                u32x2 w; w.x = cvt_pk_bf16(x[0], x[1]); w.y = cvt_pk_bf16(x[2], x[3]); *(u32x2*)(dst + (lane + 64 * j) * 4) = w; }
            s = wave_sum(s);
            if (isx) { if (lane < 16) ((float*)(ws + WS_SSQ))[(size_t)r * 16 + lane] = lane == 0 ? s : 0.f; }
            else if (lane == 0) ((float*)(ws + WS_RSMEM))[r] = rsqrtf(s * (1.f / D) + EPS); }
    }
    LAS float* Wr = (LAS float*)lds; LAS float* Wi = Wr + 2 * NP * SG; LAS float* Cr = Wi + 2 * NP * SG; LAS float* Ci = Cr + SG * NP;
    for (int _r = 0; _r < ((REP_MASK >> 17) & 1 ? 2 : 1); ++_r)
    for (int it = bid; it < 2 * NGR * (CH / 2); it += G) {
        const int kp = it % (CH / 2), g = (it / (CH / 2)) % NGR, l = (it / (CH / 2)) / NGR;
        __syncthreads();
        if (tid < 128) {
            const int kk = tid >> 6, p = tid & 63;
            const float lr = a->in[I_LRE][(l * NGR + g) * NP + p], li = a->in[I_LIM][(l * NGR + g) * NP + p], dt = expf(a->in[I_LDT][l * NGR + g]);
            float zr, zi, pr, pi; zcoef(lr, li, dt, zr, zi); lam_pow(lr, li, dt, (float)(2 * kp + kk), pr, pi);
            const float wr_ = pr * zr - pi * zi, wi_ = pr * zi + pi * zr;
            const f32x4* br = (const f32x4*)(a->in[I_BRE] + ((size_t)(l * NGR + g) * NP + p) * SG); const f32x4* bi = (const f32x4*)(a->in[I_BIM] + ((size_t)(l * NGR + g) * NP + p) * SG);
#pragma unroll
            for (int i4 = 0; i4 < 4; ++i4) { const f32x4 b_r = br[i4], b_i = bi[i4];
                *(LAS f32x4*)(Wr + (kk * NP + p) * SG + 4 * i4) = b_r * wr_ - b_i * wi_; *(LAS f32x4*)(Wi + (kk * NP + p) * SG + 4 * i4) = b_i * wr_ + b_r * wi_; }
        } else if (tid < 384) {
            const int q = tid - 128;
            *(LAS f32x4*)(Cr + q * 4) = *(const f32x4*)(a->in[I_CRE] + (size_t)(l * NGR + g) * SG * NP + q * 4);
            *(LAS f32x4*)(Ci + q * 4) = *(const f32x4*)(a->in[I_CIM] + (size_t)(l * NGR + g) * SG * NP + q * 4);
        }
        __syncthreads();
        const int kk = tid >> 8, o = (tid >> 4) & 15, i = tid & 15;
        float s = 0.f;
#pragma unroll 16
        for (int p = 0; p < NP; ++p) s += Cr[o * NP + p] * Wr[(kk * NP + p) * SG + i] - Ci[o * NP + p] * Wi[(kk * NP + p) * SG + i];
        ((float*)(ws + WS_KTAB))[(((size_t)(l * NGR + g) * 64 + 2 * kp + kk) * SG + o) * SG + i] = s;
    }
    __syncthreads();
}

__device__ __forceinline__ void mix_side(int l, LAS unsigned char* lds, int tid, int lane, int wave, int bid, int G) {
    asm volatile("" : "+v"(tid), "+v"(lane));
    KArgs a = kargs();
    unsigned char* ws = a->ws;
    {
        bf16_t* tc = (bf16_t*)(ws + WS_TCAT); const float* kt = (const float*)(ws + WS_KTAB) + (size_t)l * NGR * 64 * 256;
        const int nskip = (GROWS / BM < G) ? GROWS / BM : 0, vb = bid - nskip, VG = G - nskip;
        if (vb >= 0) {
#pragma unroll 4
            for (int it = vb * 512 + tid; it < NGR * NTOK * (NTOK / 8); it += VG * 512) {
                const int k8 = it % (NTOK / 8) + 16, n = (it / (NTOK / 8)) % NTOK, g = it / (NTOK * (NTOK / 8)), t = n >> 4, o = n & 15;
                const int kk = k8 * 8 - 128, s = kk >> 4, i0 = kk & 15, lag = t - s;
                if ((s >> 4) > (t >> 4)) continue;
                u32x4 w = {0u, 0u, 0u, 0u};
                if (lag >= 0) { const float* q = kt + ((size_t)(g * 64 + lag) * SG + o) * SG + i0; w = pack8(*(const f32x4*)q, *(const f32x4*)(q + 4)); }
                *(u32x4*)(tc + ((size_t)(g * NTOK + n) * KCAT + k8 * 8)) = w;
            }
            for (int it = vb * 512 + tid; it < NGR * NTOK * 16; it += VG * 512) {
                const int k8 = it & 15, n = (it >> 4) % NTOK, g = it / (NTOK * 16), t = n >> 4, o = n & 15;
                const int p0 = (k8 * 8) & 63; const bool im = k8 >= 8;
                const float dt = expf(a->in[I_LDT][l * NGR + g]);
                float v[8];
#pragma unroll
                for (int e = 0; e < 8; ++e) {
                    const int p = p0 + e;
                    const float lr = a->in[I_LRE][(l * NGR + g) * NP + p], li = a->in[I_LIM][(l * NGR + g) * NP + p];
                    const float cr = a->in[I_CRE][((size_t)(l * NGR + g) * SG + o) * NP + p], ci = a->in[I_CIM][((size_t)(l * NGR + g) * SG + o) * NP + p];
                    float pr, pi; lam_pow(lr, li, dt, (float)(t + 1), pr, pi);
                    v[e] = im ? -(cr * pi + ci * pr) : (cr * pr - ci * pi);
                }
                u32x4 w; w.x = cvt_pk_bf16(v[0], v[1]); w.y = cvt_pk_bf16(v[2], v[3]); w.z = cvt_pk_bf16(v[4], v[5]); w.w = cvt_pk_bf16(v[6], v[7]);
                *(u32x4*)(tc + ((size_t)(g * NTOK + n) * KCAT + k8 * 8)) = w;
            }
        }
    }
    const bf16_t* zpc = (const bf16_t*)(ws + WS_ZPC); bf16_t* ymix = (bf16_t*)(ws + WS_YMIX);
    const int pskip = (GROWS / BM < G) ? GROWS / BM : 0;
    if (bid >= pskip)
    for (int it = (bid - pskip) * 512 + tid; it < (M / 64) * 4 * 64; it += (G - pskip) * 512) {
        const int ln = it & 63, g4 = (it >> 6) & 3, tbhi = it >> 8, tb = tbhi * 8 + (ln >> 3), c8 = g4 * 64 + (ln & 7) * 8, row0 = tb * 8, t0 = row0 & (S - 1);
        const int w = 2 << g4;
        f32x4 p0[24], p1[24];
#pragma unroll
        for (int i = 0; i < 24; ++i) {
            f32x4 x0 = {0.f, 0.f, 0.f, 0.f}, x1 = x0;
            if (i >= 16 - w && i > 0 && t0 - 16 + i >= 0) unpack8(*(const u32x4*)(zpc + (size_t)(row0 - 16 + i) * D + c8), x0, x1);
            if (i == 0) { p0[0] = x0; p1[0] = x1; } else { p0[i] = p0[i - 1] + x0; p1[i] = p1[i - 1] + x1; }
        }
#pragma unroll
        for (int tt = 0; tt < 8; ++tt) {
            const int i = 16 + tt, t = t0 + tt, n = (t + 1 < w) ? t + 1 : w; const float inv = 1.f / (float)n;
            f32x4 lo0, lo1;
            if (w == 2) { lo0 = p0[i - 2]; lo1 = p1[i - 2]; } else if (w == 4) { lo0 = p0[i - 4]; lo1 = p1[i - 4]; } else if (w == 8) { lo0 = p0[i - 8]; lo1 = p1[i - 8]; } else { lo0 = p0[i - 16]; lo1 = p1[i - 16]; }
            const f32x4 u0 = p0[i] - p0[i - 1], u1 = p1[i] - p1[i - 1];
            *(u32x4*)(ymix + (size_t)(row0 + tt) * D + DSSM + c8) = pack8((p0[i] - lo0) * inv - u0, (p1[i] - lo1) * inv - u1);
        }
    }
    LAS float* hs = (LAS float*)lds;
    LAS float* cs = hs + 62 * DCONV;
    const float* cw = a->in[I_CW] + (size_t)l * CW * DCONV; const float* cb = a->in[I_CB] + l * DCONV;
    const float* lg = a->in[I_LNG] + l * DCONV; const float* lb = a->in[I_LNB] + l * DCONV;
    float wj[CW]; float bias;
    { const int c = tid % DCONV; bias = cb[c];
#pragma unroll
      for (int j = 0; j < CW; ++j) wj[j] = cw[j * DCONV + c]; }
    for (int tile = bid; tile < M / 32; tile += G) {
        const int row0 = tile * 32, t0 = row0 & (S - 1);
        __syncthreads();
        for (int it = tid; it < 62 * 48; it += 512) {
            const int r = it / 48, c8 = (it % 48) * 8, t = t0 - 30 + r;
            f32x4 h0 = {0.f, 0.f, 0.f, 0.f}, h1 = h0;
            if (t >= 0) {
                f32x4 v0, v1, g0, g1;
                unpack8(*(const u32x4*)(zpc + (size_t)(row0 - 30 + r) * D + DPOOL + c8), v0, v1);
                unpack8(*(const u32x4*)(zpc + (size_t)(row0 - 30 + r) * D + DPOOL + DCONV + c8), g0, g1);
#pragma unroll
                for (int e = 0; e < 4; ++e) { h0[e] = v0[e] * fsigm(g0[e]); h1[e] = v1[e] * fsigm(g1[e]); }
            }
            *(LAS f32x4*)(hs + r * DCONV + c8) = h0; *(LAS f32x4*)(hs + r * DCONV + c8 + 4) = h1;
        }
        __syncthreads();
        if (tid < DCONV) {
            const int c = tid;
#pragma unroll
            for (int half = 0; half < 2; ++half) {
                float hv[46];
#pragma unroll
                for (int i = 0; i < 46; ++i) hv[i] = hs[(half * 16 + i) * DCONV + c];
#pragma unroll
                for (int t = 0; t < 16; ++t) { float o = bias;
#pragma unroll
                    for (int j = 0; j < CW; ++j) o += wj[j] * hv[t + j];
                    cs[(half * 16 + t) * DCONV + c] = o; }
            }
        }
        __syncthreads();
#pragma unroll
        for (int q = 0; q < 4; ++q) {
            const int tt = wave * 4 + q; float v[6]; float s = 0.f;
#pragma unroll
            for (int e = 0; e < 6; ++e) { v[e] = cs[tt * DCONV + lane * 6 + e]; s += v[e]; }
            const float mu = wave_sum(s) * (1.f / DCONV); float qq = 0.f;
#pragma unroll
            for (int e = 0; e < 6; ++e) { v[e] -= mu; qq += v[e] * v[e]; }
            const float r = rsqrtf(wave_sum(qq) * (1.f / DCONV) + EPS);
#pragma unroll
            for (int e = 0; e < 6; ++e) { const int c = lane * 6 + e; const float h = v[e] * r * lg[c] + lb[c]; v[e] = h * fsigm(h); }
            unsigned* op = (unsigned*)(ymix + (size_t)(row0 + tt) * D + DSSM + DPOOL + lane * 6);
            op[0] = cvt_pk_bf16(v[0], v[1]); op[1] = cvt_pk_bf16(v[2], v[3]); op[2] = cvt_pk_bf16(v[4], v[5]);
        }
    }
    __syncthreads();
}

template <class SchedT>
__device__ __forceinline__ void s2_local(int l, const SchedT& Sd, int tid) {
    asm volatile("" : "+v"(tid));
    KArgs a = kargs();
    unsigned char* ws = a->ws;
    const float* xloc = (const float*)(ws + WS_XLOC); bf16_t* ucat = (bf16_t*)(ws + WS_UCAT);
    Unit u; int prev = -1;
    for (int i = 0; Sd.next(i, u); ++i) {
        if (u.pm == prev) continue;
        prev = u.pm;
        if (tid < 256) {
            const int p = tid & 63, g = u.pm / (NCH / BM), b = (u.pm % (NCH / BM)) * (BM / (S / CH)) + (tid >> 6);
            const float lr = a->in[I_LRE][(l * NGR + g) * NP + p], li = a->in[I_LIM][(l * NGR + g) * NP + p], dt = expf(a->in[I_LDT][l * NGR + g]);
            float ar, ai; lam_pow(lr, li, dt, (float)CH, ar, ai);
            float xr = 0.f, xi = 0.f;
#pragma unroll 1
            for (int h = 0; h < S / CH / 32; ++h) {
                const size_t rowb = (size_t)g * NCH + b * (S / CH) + h * 32;
                float lr_[32], li_[32];
#pragma unroll
                for (int c = 0; c < 32; ++c) { lr_[c] = xloc[(rowb + c) * 128 + p]; li_[c] = xloc[(rowb + c) * 128 + 64 + p]; }
#pragma unroll
                for (int c = 0; c < 32; ++c) {
                    ucat[(rowb + c) * KCAT + p] = (bf16_t)(cvt_pk_bf16(xr, 0.f) & 0xffffu); ucat[(rowb + c) * KCAT + 64 + p] = (bf16_t)(cvt_pk_bf16(xi, 0.f) & 0xffffu);
                    const float nr = ar * xr - ai * xi + lr_[c], ni = ar * xi + ai * xr + li_[c]; xr = nr; xi = ni;
                }
            }
        }
    }
    asm volatile("s_waitcnt vmcnt(0)" ::: "memory");
    __syncthreads();
}

__device__ __forceinline__ void final_norm(int lane, int wave, int bid, int G) {
    KArgs a = kargs();
    const float* ssq = (const float*)(a->ws + WS_SSQ); const f32x4* gn = (const f32x4*)a->in[I_FN]; const bf16_t* xb = (const bf16_t*)(a->ws + WS_XB);
    const f32x4 g0 = gn[lane * 2], g1 = gn[lane * 2 + 1], g2 = gn[128 + lane * 2], g3 = gn[128 + lane * 2 + 1];
    for (int row = bid * 8 + wave; row < M; row += G * 8) {
        float s = lane < 16 ? ssq[(size_t)row * 16 + lane] : 0.f; s = wave_sum(s);
        const float r = rsqrtf(s * (1.f / D) + EPS);
        const u32x4 w0 = *(const u32x4*)(xb + (size_t)row * D + lane * 8), w1 = *(const u32x4*)(xb + (size_t)row * D + 512 + lane * 8);
        f32x4 a0, a1, b0, b1; unpack8(w0, a0, a1); unpack8(w1, b0, b1);
        f32x4* o = (f32x4*)(a->out + (size_t)row * D);
        __builtin_nontemporal_store(a0 * r * g0, o + lane * 2); __builtin_nontemporal_store(a1 * r * g1, o + lane * 2 + 1); __builtin_nontemporal_store(b0 * r * g2, o + 128 + lane * 2); __builtin_nontemporal_store(b1 * r * g3, o + 128 + lane * 2 + 1);
    }
}
#ifndef MK_CG_ALL
#define MK_CG_ALL 0
#endif
constexpr int N_PHASES = 31;
__global__ void __launch_bounds__(512, 2) mk_fwd(Args a) {
    extern __shared__ __attribute__((aligned(16))) unsigned char lds_raw[];
    LAS unsigned char* lds = (LAS unsigned char*)lds_raw;
    cg::grid_group grid = cg::this_grid();
    const int tid = threadIdx.x, lane = tid & 63, wave = __builtin_amdgcn_readfirstlane(tid >> 6), bid = blockIdx.x, G = gridDim.x;
    unsigned char* ws = kargs()->ws;
    volatile LAS unsigned* misc = (volatile LAS unsigned*)(lds + MISC_OFF);
    if (tid < 16) misc[tid] = 0u;
    __syncthreads();
    XcdBarrier bar = xcd_barrier_post((unsigned*)(ws + WS_CTL), misc);
    const int lo = kargs()->ph_lo, hi = kargs()->ph_hi;
#define PH(k) if (lo <= (k) && (k) < hi)
#ifndef REP_MASK
#define REP_MASK 0
#endif
#define PHK(k, kind) for (int _r = 0; _r < ((((REP_MASK) >> (kind)) & 1) ? 2 : 1); ++_r) if (lo <= (k) && (k) < hi)
#define SEAM(k) do { if (lo <= (k) && (k) + 1 < hi) { if (MK_CG_ALL) grid.sync(); else { xcd_barrier(bar); if ((REP_MASK >> 10) & 1) xcd_barrier(bar); } } } while (0)
    const size_t RT1024 = 524288;
    float* ssq = (float*)(ws + WS_SSQ); bf16_t* xb = (bf16_t*)(ws + WS_XB);

    if (lo < 0) grid.sync();
    PHK(0, 0) { p0a(lds, tid, lane, wave, bid, G); }
    SEAM(0);
    PHK(1, 1) {
        Gemm g{ws, ws, D, D, D, 0, 0}; Sched S; S.init(1, 256, G, bid); S.kv = 1; S.kv_memb = WS_MEMB;
        S.kv_wk0 = WS_WL + WL_K; S.kv_wk1 = WS_WL + WL_STRIDE + WL_K; S.kv_wv0 = WS_WL + WL_V; S.kv_wv1 = WS_WL + WL_STRIDE + WL_V;
        EpiKV E{(bf16_t*)(ws + WS_KV), (bf16_t*)(ws + WS_KV + 16 * MiB), (const float*)(ws + WS_RSMEM)};
        gemm_phase(lds, g, S, E);
    }
#pragma unroll 1
    for (int l = 0; l < 2; ++l) {
        const int pb = 2 + 14 * l;
        unsigned char* wl = ws + WS_WL + (size_t)l * WL_STRIDE;
#pragma unroll 1
        for (int f = 0; f < 2; ++f) {
            const int p0 = pb + (f ? 12 : 0);
            PHK(p0, 2) {
                Gemm g{ws + WS_XB, wl + (f ? WL_GU2 : WL_GU1), D, D, D, 0, 0}; Sched S; S.init(M / BM, 2 * DFF / BM, G, bid); S.aM = RT1024; S.bN = RT1024;
                EpiSwiglu E{(bf16_t*)(ws + WS_ACT), ssq};
                gemm_phase(lds, g, S, E);
            }
            SEAM(p0);
            PHK(p0 + 1, 9) {
                Gemm g{ws + WS_ACT, wl + (f ? WL_D2 : WL_D1), DFF, DFF, DFF, 1, 1}; Sched S; S.init(M / BM, D / BM, G, bid); S.aM = (size_t)BM * DFF * 2; S.bN = (size_t)BM * DFF * 2;
                EpiResid E{xb, ssq, ((REP_MASK >> 9) & 1) ? 0.25f : 0.5f};
                gemm_phase(lds, g, S, E);
            }
            SEAM(p0 + 1);
            if (f == 1) break;
            PHK(pb + 2, 3) {
                Gemm g{ws + WS_XB, wl + WL_IN, D, D, D, 0, 0}; Sched S; S.init(M / BM, 6, G, bid); S.aM = RT1024; S.bN = RT1024;
                EpiWin E{(bf16_t*)(ws + WS_UCAT), (bf16_t*)(ws + WS_ZPC), ssq};
                gemm_phase(lds, g, S, E);
            }
            SEAM(pb + 2);
            PHK(pb + 3, 4) {
                Gemm g{ws + WS_UCAT, wl + WL_GM, KCAT, NTOK, NTOK, 0, 0}; Sched S; S.init(GROWS / BM, 1, G, bid); S.a0 = 256; S.aM = (size_t)BM * KCAT * 2; S.bdiv = NCH / BM; S.bM = (size_t)128 * NTOK * 2;
                EpiXloc E{(float*)(ws + WS_XLOC)};
                gemm_phase(lds, g, S, E);
                mix_side(l, lds, tid, lane, wave, bid, G);
            }
            SEAM(pb + 3);
            PHK(pb + 5, 6) {
                Gemm g{ws + WS_UCAT, ws + WS_TCAT, KCAT, KCAT, KCAT, 0, 0}; Sched S; S.init(GROWS / BM, NTOK / BM, G, bid); S.aM = (size_t)BM * KCAT * 2; S.bN = (size_t)BM * KCAT * 2; S.bdiv = NCH / BM; S.bM = (size_t)(NTOK / BM) * BM * KCAT * 2; S.causal = 1;
                s2_local(l, S, tid);
                EpiS5 E{(const bf16_t*)(ws + WS_UCAT), (bf16_t*)(ws + WS_YG), kargs()->in[I_SD] + l * DSSM};
                gemm_phase(lds, g, S, E);
            }
            SEAM(pb + 5);
            PHK(pb + 6, 7) {
                Gemm g{ws + WS_YG, wl + WL_GLU, DSSM, DSSM, DSSM, 0, 0}; Sched S; S.init(M / BM, 2, G, bid); S.aM = (size_t)BM * DSSM * 2; S.bN = (size_t)BM * DSSM * 2;
                EpiGlu E{(const bf16_t*)(ws + WS_YG), (bf16_t*)(ws + WS_YMIX)};
                gemm_phase(lds, g, S, E);
            }
            SEAM(pb + 6);
            PH(pb + 7) {
                Gemm g{ws + WS_YMIX, wl + WL_OUT, D, D, D, 0, 0}; Sched S; S.init(M / BM, D / BM, G, bid); S.aM = RT1024; S.bN = RT1024;
                EpiResid E{xb, ssq, 1.0f};
                gemm_phase(lds, g, S, E);
            }
            SEAM(pb + 7);
            PHK(pb + 8, 8) {
                Gemm g{ws + WS_XB, wl + WL_Q, D, D, D, 0, 0}; Sched S; S.init(M / BM, D / BM, G, bid); S.aM = RT1024; S.bN = RT1024;
                EpiRowScale E{(bf16_t*)(ws + WS_Q), D, ssq};
                gemm_phase(lds, g, S, E);
            }
            PHK(pb + 9, 11) {
                Gemm g{ws + WS_Q, ws + WS_KV + (size_t)l * 8 * MiB, D, D, 256, 0, 0}; Sched S; S.init(M / BM, 4, G, bid); S.aM = RT1024; S.aN = 512; S.bN = 512; S.bdiv = 8; S.bM = RT1024;
                EpiSoftmax E{(bf16_t*)(ws + WS_YMIX)};
                gemm_phase(lds, g, S, E);
            }
            PHK(pb + 10, 12) {
                Gemm g{ws + WS_YMIX, ws + WS_KV + (size_t)(2 + l) * 8 * MiB, D, MM, 256, 0, 0}; Sched S; S.init(M / BM, 4, G, bid); S.aM = RT1024; S.aN = 512; S.bN = (size_t)BM * MM * 2; S.bdiv = 8; S.bM = 512;
                EpiRowScale E{(bf16_t*)(ws + WS_Q), D, nullptr};
                gemm_phase(lds, g, S, E);
            }
            SEAM(pb + 10);
            PH(pb + 11) {
                Gemm g{ws + WS_Q, wl + WL_O, D, D, D, 0, 0}; Sched S; S.init(M / BM, D / BM, G, bid); S.aM = RT1024; S.bN = RT1024;
                EpiResid E{xb, ssq, 1.0f};
                gemm_phase(lds, g, S, E);
            }
            SEAM(pb + 11);
        }
    }
    PH(30) { final_norm(lane, wave, bid, G); }
#undef PH
#undef SEAM
}
}

#ifndef ENG_PHASES
#define ENG_PHASES 31
#endif
extern "C" void kernel_launch(void* const* d_in, const int* in_sizes, int n_in, void* d_out, int out_size, void* d_ws, size_t ws_size, hipStream_t stream) {
    static int grid = 0;
    if (grid == 0) {
        int dev = 0, cus = 0, per_cu = 0;
        if (ws_size < mk::WS_END || n_in != 35) { fprintf(stderr, "kernel_launch: bad ws/n_in\n"); grid = -1; return; }
        hipGetDevice(&dev); hipDeviceGetAttribute(&cus, hipDeviceAttributeMultiprocessorCount, dev);
        if (hipFuncSetAttribute((const void*)mk::mk_fwd, hipFuncAttributeMaxDynamicSharedMemorySize, mk::LDS_BYTES) != hipSuccess) { fprintf(stderr, "kernel_launch: hipFuncSetAttribute failed\n"); grid = -1; return; }
        if (hipOccupancyMaxActiveBlocksPerMultiprocessor(&per_cu, (const void*)mk::mk_fwd, 512, mk::LDS_BYTES) != hipSuccess || per_cu < 1) fprintf(stderr, "kernel_launch: occupancy query says %d\n", per_cu);
        (void)hipGetLastError();
        grid = cus;
    }
    if (grid < 0) return;
    hipMemsetAsync((char*)d_ws + mk::WS_CTL, 0, 16384, stream);
    mk::Args a; memset(&a, 0, sizeof(a));
    for (int i = 0; i < 35; ++i) a.in[i] = (const float*)d_in[i];
    a.out = (float*)d_out; a.ws = (unsigned char*)d_ws; a.ph_lo = 0; a.ph_hi = ENG_PHASES;
    void* args[] = {&a};
    hipError_t e = hipLaunchCooperativeKernel((const void*)mk::mk_fwd, dim3(grid), dim3(512), args, mk::LDS_BYTES, stream);
    if (e != hipSuccess) fprintf(stderr, "cooperative launch failed: %s (grid %d)\n", hipGetErrorString(e), grid);
#if ENG_PHASES < 31
    {
        const nv::In I = nv::make_in(d_in); float* x = (float*)d_out; float* ws = (float*)d_ws;
        int st = 0;
        for (int l = 0; l < 2; ++l) { const int pb = 2 + 14 * l; if (ENG_PHASES >= pb + 2) st = 4 * l + 1; if (ENG_PHASES >= pb + 8) st = 4 * l + 2; if (ENG_PHASES >= pb + 12) st = 4 * l + 3; if (ENG_PHASES >= pb + 14) st = 4 * l + 4; }
        if (st == 0) hipLaunchKernelGGL(nv::copy_k, dim3(4096), dim3(256), 0, stream, (const float4*)I.x, (float4*)x, (size_t)nv::M * nv::D / 4);
        for (int s = st; s < 8; ++s) {
            const int l = s >> 2, k = s & 3;
            if (k == 0) nv::ffn(stream, x, ws, I.ffn1_norm + l * 1024, I.ffn1_wg + (size_t)l * 1024 * 2816, I.ffn1_wu + (size_t)l * 1024 * 2816, I.ffn1_wd + (size_t)l * 2816 * 1024);
            else if (k == 1) nv::mixer(stream, x, ws, I, l);
            else if (k == 2) nv::xattn(stream, x, ws, I, l);
            else nv::ffn(stream, x, ws, I.ffn2_norm + l * 1024, I.ffn2_wg + (size_t)l * 1024 * 2816, I.ffn2_wu + (size_t)l * 1024 * 2816, I.ffn2_wd + (size_t)l * 2816 * 1024);
        }
        hipLaunchKernelGGL(nv::rmsnorm_k, dim3(nv::M / 4), dim3(256), 0, stream, x, I.final_norm, x, nv::M);
    }
#endif
}
```

```cpp
#include <hip/hip_runtime.h>
#include <hip/hip_cooperative_groups.h>
#include <cstdint>
#include <cstdio>
#include <cstring>
#ifndef REP_MASK
#define REP_MASK 0
#endif
namespace nv {
constexpr int D = 1024, NB = 16, S = 2048, M = NB * S, ML = 256, MM = NB * ML;
constexpr int DSSM = 384, DPOOL = 256, DCONV = 384, DIN = 1408, DFF = 2816, NGR = 24, SG = 16, NP = 64, CW = 31;

struct NGemm {
    const float* A; int lda; const float* B; int ldb; const float* B2; float* C; int ldc; int K;
    float alpha; const float* aux; int ldaux; const float* cs; int nh;
    long sA1, sA2, sB1, sB2, sC1, sC2;
};
__device__ __forceinline__ float sigm(float v) { return 1.f / (1.f + __expf(-v)); }

template <int EPI, int TB>
__global__ void __launch_bounds__(256) ngemm(NGemm p) {
    __shared__ float As[16][68];
    __shared__ float Bs[16][68];
    __shared__ float Bs2[EPI == 2 ? 16 : 1][68];
    const int tid = threadIdx.x, tx = tid & 15, ty = tid >> 4;
    const int z = blockIdx.z, z1 = z / p.nh, z2 = z % p.nh;
    const float* A = p.A + z1 * p.sA1 + z2 * p.sA2 + (size_t)blockIdx.y * 64 * p.lda;
    const float* B = p.B + z1 * p.sB1 + z2 * p.sB2;
    const float* B2 = p.B2;
    float* C = p.C + z1 * p.sC1 + z2 * p.sC2;
    const int n0 = blockIdx.x * 64;
    float acc[4][4], acc2[4][4];
#pragma unroll
    for (int i = 0; i < 4; ++i)
#pragma unroll
        for (int j = 0; j < 4; ++j) { acc[i][j] = 0.f; acc2[i][j] = 0.f; }
    for (int k0 = 0; k0 < p.K; k0 += 16) {
        {
            const int r = tid >> 2, kk = (tid & 3) * 4;
            const float4 v = *(const float4*)(A + (size_t)r * p.lda + k0 + kk);
            As[kk + 0][r] = v.x; As[kk + 1][r] = v.y; As[kk + 2][r] = v.z; As[kk + 3][r] = v.w;
        }
        if (TB) {
            const int n = tid >> 2, kk = (tid & 3) * 4;
            const float4 v = *(const float4*)(B + (size_t)(n0 + n) * p.ldb + k0 + kk);
            Bs[kk + 0][n] = v.x; Bs[kk + 1][n] = v.y; Bs[kk + 2][n] = v.z; Bs[kk + 3][n] = v.w;
        } else {
            const int kk = tid >> 4, n = (tid & 15) * 4;
            const float4 v = *(const float4*)(B + (size_t)(k0 + kk) * p.ldb + n0 + n);
            Bs[kk][n] = v.x; Bs[kk][n + 1] = v.y; Bs[kk][n + 2] = v.z; Bs[kk][n + 3] = v.w;
            if (EPI == 2) {
                const float4 w = *(const float4*)(B2 + (size_t)(k0 + kk) * p.ldb + n0 + n);
                Bs2[kk][n] = w.x; Bs2[kk][n + 1] = w.y; Bs2[kk][n + 2] = w.z; Bs2[kk][n + 3] = w.w;
            }
        }
        __syncthreads();
#pragma unroll
        for (int kk = 0; kk < 16; ++kk) {
            float a[4], b[4], b2[4];
#pragma unroll
            for (int i = 0; i < 4; ++i) { a[i] = As[kk][ty * 4 + i]; b[i] = Bs[kk][tx * 4 + i]; b2[i] = (EPI == 2) ? Bs2[kk][tx * 4 + i] : 0.f; }
#pragma unroll
            for (int i = 0; i < 4; ++i)
#pragma unroll
                for (int j = 0; j < 4; ++j) { acc[i][j] += a[i] * b[j]; if (EPI == 2) acc2[i][j] += a[i] * b2[j]; }
        }
        __syncthreads();
    }
#pragma unroll
    for (int i = 0; i < 4; ++i) {
        const size_t r = (size_t)blockIdx.y * 64 + ty * 4 + i;
#pragma unroll
        for (int j = 0; j < 4; ++j) {
            const int c = n0 + tx * 4 + j;
            float* o = C + r * p.ldc + c;
            const float v = acc[i][j];
            if (EPI == 0) *o = v;
            else if (EPI == 1) *o = *o + p.alpha * v;
            else if (EPI == 2) *o = v * sigm(v) * acc2[i][j];
            else if (EPI == 3) *o = p.aux[r * p.ldaux + c] * sigm(v);
            else if (EPI == 4) *o = v * p.cs[c];
            else *o = p.alpha * v;
        }
    }
}

__device__ __forceinline__ float wsum(float v) {
#pragma unroll
    for (int o = 1; o < 64; o <<= 1) v += __shfl_xor(v, o);
    return v;
}
__device__ __forceinline__ float wmax(float v) {
#pragma unroll
    for (int o = 1; o < 64; o <<= 1) v = fmaxf(v, __shfl_xor(v, o));
    return v;
}
__global__ void __launch_bounds__(256) rmsnorm_k(const float* x, const float* g, float* h, int rows) {
    const int w = (blockIdx.x * 256 + threadIdx.x) >> 6, lane = threadIdx.x & 63;
    if (w >= rows) return;
    const float4* xr = (const float4*)(x + (size_t)w * D);
    float4 v[4]; float s = 0.f;
#pragma unroll
    for (int j = 0; j < 4; ++j) { v[j] = xr[lane + 64 * j]; s += v[j].x * v[j].x + v[j].y * v[j].y + v[j].z * v[j].z + v[j].w * v[j].w; }
    const float r = rsqrtf(wsum(s) * (1.f / D) + 1e-6f);
    float4* hr = (float4*)(h + (size_t)w * D);
#pragma unroll
    for (int j = 0; j < 4; ++j) { const float4 gg = ((const float4*)g)[lane + 64 * j]; hr[lane + 64 * j] = make_float4(v[j].x * r * gg.x, v[j].y * r * gg.y, v[j].z * r * gg.z, v[j].w * r * gg.w); }
}
__global__ void copy_k(const float4* a, float4* b, size_t n4) { for (size_t i = blockIdx.x * (size_t)blockDim.x + threadIdx.x; i < n4; i += (size_t)gridDim.x * blockDim.x) b[i] = a[i]; }

__global__ void __launch_bounds__(64) s5_k(const float* z, const float* lam_re, const float* lam_im, const float* log_dt, const float* b_re, const float* b_im,
                                           const float* c_re, const float* c_im, const float* dd, float* ypre) {
    const int b = blockIdx.x / NGR, g = blockIdx.x % NGR, p = threadIdx.x;
    const float dt = expf(log_dt[g]), lr = lam_re[g * NP + p], li = lam_im[g * NP + p];
    const float mag = expf(lr * dt), ar = mag * cosf(li * dt), ai = mag * sinf(li * dt), den = lr * lr + li * li;
    const float zr = ((ar - 1.f) * lr + ai * li) / den, zi = (ai * lr - (ar - 1.f) * li) / den;
    float bbr[16], bbi[16], cr[16], ci[16];
#pragma unroll
    for (int i = 0; i < 16; ++i) {
        const float br = b_re[(g * NP + p) * SG + i], bi = b_im[(g * NP + p) * SG + i];
        bbr[i] = zr * br - zi * bi; bbi[i] = zr * bi + zi * br;
        cr[i] = c_re[(g * SG + i) * NP + p]; ci[i] = c_im[(g * SG + i) * NP + p];
    }
    const float dmine = dd[g * SG + (p & 15)];
    float xr = 0.f, xi = 0.f;
    for (int t = 0; t < S; ++t) {
        const size_t row = (size_t)b * S + t;
        const float4* up = (const float4*)(z + row * DIN + g * SG);
        const float4 u0 = up[0], u1 = up[1], u2 = up[2], u3 = up[3];
        const float u[16] = {u0.x, u0.y, u0.z, u0.w, u1.x, u1.y, u1.z, u1.w, u2.x, u2.y, u2.z, u2.w, u3.x, u3.y, u3.z, u3.w};
        float bur = 0.f, bui = 0.f;
#pragma unroll
        for (int i = 0; i < 16; ++i) { bur += bbr[i] * u[i]; bui += bbi[i] * u[i]; }
        const float nxr = ar * xr - ai * xi + bur, nxi = ar * xi + ai * xr + bui;
        xr = nxr; xi = nxi;
        float mine = 0.f, umine = 0.f;
#pragma unroll
        for (int o = 0; o < 16; ++o) { const float sv = wsum(cr[o] * xr - ci[o] * xi); if (p == o) { mine = sv; umine = u[o]; } }
        if (p < 16) {
            const float v = mine + dmine * umine;
            ypre[row * DSSM + g * SG + p] = 0.5f * v * (1.f + tanhf(0.7978845608028654f * (v + 0.044715f * v * v * v)));
        }
    }
}
__global__ void pool_k(const float* z, float* pp) {
    const size_t i = blockIdx.x * (size_t)blockDim.x + threadIdx.x;
    if (i >= (size_t)M * DPOOL) return;
    const size_t row = i / DPOOL; const int c = (int)(i % DPOOL), t = (int)(row % S), w = 2 << (c / 64);
    const int n = (t + 1 < w) ? t + 1 : w;
    float s = 0.f;
    for (int j = 0; j < n; ++j) s += z[(row - j) * DIN + DSSM + c];
    pp[i] = s / (float)n - z[row * DIN + DSSM + c];
}
__global__ void conv_k(const float* z, const float* cw, const float* cbias, float* cb) {
    const size_t i = blockIdx.x * (size_t)blockDim.x + threadIdx.x;
    if (i >= (size_t)M * DCONV) return;
    const size_t row = i / DCONV; const int c = (int)(i % DCONV), t = (int)(row % S);
    float s = cbias[c];
    for (int j = 0; j < CW; ++j) {
        const int tt = t - (CW - 1) + j;
        if (tt < 0) continue;
        const size_t r2 = row - (CW - 1) + j;
        const float v = z[r2 * DIN + DSSM + DPOOL + c], g = z[r2 * DIN + DSSM + DPOOL + DCONV + c];
        s += cw[j * DCONV + c] * v * sigm(g);
    }
    cb[i] = s;
}
__global__ void __launch_bounds__(256) convln_k(const float* cb, const float* g, const float* bta, float* ymix) {
    const int w = (blockIdx.x * 256 + threadIdx.x) >> 6, lane = threadIdx.x & 63;
    if (w >= M) return;
    float v[6]; float s = 0.f;
#pragma unroll
    for (int j = 0; j < 6; ++j) { v[j] = cb[(size_t)w * DCONV + lane + 64 * j]; s += v[j]; }
    const float mu = wsum(s) * (1.f / DCONV); float q = 0.f;
#pragma unroll
    for (int j = 0; j < 6; ++j) { v[j] -= mu; q += v[j] * v[j]; }
    const float r = rsqrtf(wsum(q) * (1.f / DCONV) + 1e-6f);
#pragma unroll
    for (int j = 0; j < 6; ++j) { const int c = lane + 64 * j; const float h = v[j] * r * g[c] + bta[c]; ymix[(size_t)w * D + DSSM + DPOOL + c] = h * sigm(h); }
}
__global__ void __launch_bounds__(256) softmax_k(float* sc, size_t rows) {
    const size_t w = (blockIdx.x * (size_t)256 + threadIdx.x) >> 6; const int lane = threadIdx.x & 63;
    if (w >= rows) return;
    float4* r = (float4*)(sc + w * 256);
    float4 v = r[lane];
    const float mx = wmax(fmaxf(fmaxf(v.x, v.y), fmaxf(v.z, v.w)));
    v.x = __expf(v.x - mx); v.y = __expf(v.y - mx); v.z = __expf(v.z - mx); v.w = __expf(v.w - mx);
    const float inv = 1.f / wsum(v.x + v.y + v.z + v.w);
    r[lane] = make_float4(v.x * inv, v.y * inv, v.z * inv, v.w * inv);
}

struct In {
    const float *x, *mem, *ffn1_norm, *ffn1_wg, *ffn1_wu, *ffn1_wd, *mix_norm, *w_in, *w_out, *lam_re, *lam_im, *log_dt, *b_re, *b_im, *c_re, *c_im, *ssm_d, *w_glu,
        *pool_w, *pool_scale, *conv_w, *conv_b, *ln_g, *ln_b, *xattn_norm, *mem_norm, *wq, *wk, *wv, *wo, *ffn2_norm, *ffn2_wg, *ffn2_wu, *ffn2_wd, *final_norm;
};
static In make_in(void* const* d) {
    In I; const float** f = (const float**)&I;
    for (int i = 0; i < 35; ++i) f[i] = (const float*)d[i];
    return I;
}
template <int EPI, int TB>
static void gemm(hipStream_t st, int Mr, int N, int K, const float* A, int lda, const float* B, int ldb, float* C, int ldc, float alpha = 1.f, const float* B2 = nullptr,
                 const float* aux = nullptr, int ldaux = 0, const float* cs = nullptr, int nz = 1, int nh = 1, long sA1 = 0, long sA2 = 0, long sB1 = 0, long sB2 = 0, long sC1 = 0, long sC2 = 0) {
    NGemm p; memset(&p, 0, sizeof(p));
    p.A = A; p.lda = lda; p.B = B; p.ldb = ldb; p.B2 = B2; p.C = C; p.ldc = ldc; p.K = K; p.alpha = alpha; p.aux = aux; p.ldaux = ldaux; p.cs = cs; p.nh = nh;
    p.sA1 = sA1; p.sA2 = sA2; p.sB1 = sB1; p.sB2 = sB2; p.sC1 = sC1; p.sC2 = sC2;
    hipLaunchKernelGGL((ngemm<EPI, TB>), dim3(N / 64, Mr / 64, nz), dim3(256), 0, st, p);
}
constexpr size_t R0 = 0, R1 = (size_t)M * D, R2 = R1 + (size_t)M * DIN, R3 = R2 + (size_t)M * D, REND = R3 + (size_t)M * DSSM;

static void ffn(hipStream_t st, float* x, float* ws, const float* nrm, const float* wg, const float* wu, const float* wd) {
    float* h = ws + R0; float* act = ws + R1;
    hipLaunchKernelGGL(rmsnorm_k, dim3(M / 4), dim3(256), 0, st, x, nrm, h, M);
    for (int ch = 0; ch < 4; ++ch) {
        gemm<2, 0>(st, M, 704, D, h, D, wg + ch * 704, DFF, act, 704, 1.f, wu + ch * 704);
        gemm<1, 0>(st, M, D, 704, act, 704, wd + (size_t)ch * 704 * D, D, x, D, 0.5f);
    }
}
static void mixer(hipStream_t st, float* x, float* ws, const In& I, int l) {
    float* h = ws + R0; float* z = ws + R1; float* ymix = ws + R2; float* ypre = ws + R3; float* pp = ws + R0; float* cb = ws + R0 + (size_t)M * DPOOL;
    hipLaunchKernelGGL(rmsnorm_k, dim3(M / 4), dim3(256), 0, st, x, I.mix_norm + l * D, h, M);
    gemm<0, 0>(st, M, DIN, D, h, D, I.w_in + (size_t)l * D * DIN, DIN, z, DIN);
    hipLaunchKernelGGL(s5_k, dim3(NB * NGR), dim3(64), 0, st, z, I.lam_re + l * NGR * NP, I.lam_im + l * NGR * NP, I.log_dt + l * NGR, I.b_re + (size_t)l * NGR * NP * SG, I.b_im + (size_t)l * NGR * NP * SG,
                       I.c_re + (size_t)l * NGR * SG * NP, I.c_im + (size_t)l * NGR * SG * NP, I.ssm_d + l * DSSM, ypre);
    gemm<3, 0>(st, M, DSSM, DSSM, ypre, DSSM, I.w_glu + (size_t)l * DSSM * DSSM, DSSM, ymix, D, 1.f, nullptr, ypre, DSSM);
    hipLaunchKernelGGL(pool_k, dim3((M * DPOOL) / 256), dim3(256), 0, st, z, pp);
    for (int g = 0; g < 4; ++g)
        gemm<4, 0>(st, M, 64, 64, pp + g * 64, DPOOL, I.pool_w + (size_t)(l * 4 + g) * 64 * 64, 64, ymix + DSSM + g * 64, D, 1.f, nullptr, nullptr, 0, I.pool_scale + l * DPOOL + g * 64);
    hipLaunchKernelGGL(conv_k, dim3((M * DCONV) / 256), dim3(256), 0, st, z, I.conv_w + (size_t)l * CW * DCONV, I.conv_b + l * DCONV, cb);
    hipLaunchKernelGGL(convln_k, dim3(M / 4), dim3(256), 0, st, cb, I.ln_g + l * DCONV, I.ln_b + l * DCONV, ymix);
    gemm<1, 0>(st, M, D, D, ymix, D, I.w_out + (size_t)l * D * D, D, x, D, 1.f);
}
static void xattn(hipStream_t st, float* x, float* ws, const In& I, int l) {
    float* h = ws + R0; float* q = ws + R2; float* mn = ws + R3; float* k = ws + R3 + (size_t)MM * D; float* v = ws + R3 + (size_t)2 * MM * D; float* sc = ws + R1; float* o = ws + R0;
    hipLaunchKernelGGL(rmsnorm_k, dim3(M / 4), dim3(256), 0, st, x, I.xattn_norm + l * D, h, M);
    hipLaunchKernelGGL(rmsnorm_k, dim3(MM / 4), dim3(256), 0, st, I.mem, I.mem_norm + l * D, mn, MM);
    gemm<0, 0>(st, M, D, D, h, D, I.wq + (size_t)l * D * D, D, q, D);
    gemm<0, 0>(st, MM, D, D, mn, D, I.wk + (size_t)l * D * D, D, k, D);
    gemm<0, 0>(st, MM, D, D, mn, D, I.wv + (size_t)l * D * D, D, v, D);
    gemm<5, 1>(st, S, ML, 256, q, D, k, D, sc, ML, 1.f / 16.f, nullptr, nullptr, 0, nullptr, NB * 4, 4, (long)S * D, 256, (long)ML * D, 256, (long)4 * S * ML, (long)S * ML);
    hipLaunchKernelGGL(softmax_k, dim3((unsigned)((size_t)NB * 4 * S / 4)), dim3(256), 0, st, sc, (size_t)NB * 4 * S);
    gemm<0, 0>(st, S, 256, ML, sc, ML, v, D, o, D, 1.f, nullptr, nullptr, 0, nullptr, NB * 4, 4, (long)4 * S * ML, (long)S * ML, (long)ML * D, 256, (long)S * D, 256);
    gemm<1, 0>(st, M, D, D, o, D, I.wo + (size_t)l * D * D, D, x, D, 1.f);
}
static void forward(hipStream_t st, void* const* d_in, float* out, float* ws) {
    const In I = make_in(d_in);
    float* x = out;
    hipLaunchKernelGGL(copy_k, dim3(4096), dim3(256), 0, st, (const float4*)I.x, (float4*)x, (size_t)M * D / 4);
    for (int l = 0; l < 2; ++l) {
        ffn(st, x, ws, I.ffn1_norm + l * D, I.ffn1_wg + (size_t)l * D * DFF, I.ffn1_wu + (size_t)l * D * DFF, I.ffn1_wd + (size_t)l * DFF * D);
        mixer(st, x, ws, I, l);
        xattn(st, x, ws, I, l);
        ffn(st, x, ws, I.ffn2_norm + l * D, I.ffn2_wg + (size_t)l * D * DFF, I.ffn2_wu + (size_t)l * D * DFF, I.ffn2_wd + (size_t)l * DFF * D);
    }
    hipLaunchKernelGGL(rmsnorm_k, dim3(M / 4), dim3(256), 0, st, x, I.final_norm, x, M);
}
}
namespace mk {
namespace cg = cooperative_groups;
#define LAS __attribute__((address_space(3)))
#define GAS __attribute__((address_space(1)))
typedef unsigned short bf16_t;
typedef short bf16x8 __attribute__((ext_vector_type(8)));
typedef float f32x4 __attribute__((ext_vector_type(4)));
typedef float f32x2 __attribute__((ext_vector_type(2)));
typedef unsigned u32x4 __attribute__((ext_vector_type(4)));
typedef unsigned u32x2 __attribute__((ext_vector_type(2)));
constexpr int BM = 256, BK = 64, HALF = 128, HTB = HALF * BK * 2, STAGE_BYTES = 8 * HTB, NXCD = 8, WGM = 8;
constexpr int XCH_OFF = STAGE_BYTES, MISC_OFF = 147456, LDS_BYTES = MISC_OFF + 256;

constexpr int D = 1024, NB = 16, S = 2048, M = NB * S, ML = 256, MM = NB * ML;
constexpr int DSSM = 384, DPOOL = 256, DCONV = 384, DIN = 1408, DFF = 2816, NGR = 24, SG = 16, NP = 64, CW = 31;
constexpr int CH = 32  , NCH = M / CH  , NTOK = CH * SG  , KCAT = 128 + NTOK  , GROWS = NGR * NCH  ;
constexpr float EPS = 1e-6f;

constexpr size_t MiB = 1u << 20;
constexpr size_t WS_CTL = 0;
constexpr size_t WS_WL = 1 * MiB;
constexpr size_t WL_GU1 = 0, WL_D1 = 11 * MiB, WL_GU2 = WL_D1 + 5767168, WL_D2 = WL_GU2 + 11 * MiB, WL_IN = WL_D2 + 5767168, WL_OUT = WL_IN + 3 * MiB,
                 WL_Q = WL_OUT + 2 * MiB, WL_K = WL_Q + 2 * MiB, WL_V = WL_K + 2 * MiB, WL_O = WL_V + 2 * MiB, WL_GLU = WL_O + 2 * MiB, WL_GM = WL_GLU + MiB / 2,
                 WL_STRIDE = WL_GM + 6553600;
constexpr size_t WS_KTAB = WS_WL + 2 * WL_STRIDE;
constexpr size_t WS_TCAT = WS_KTAB + 3 * MiB;
constexpr size_t WS_XB = WS_TCAT + 54 * MiB;
constexpr size_t WS_ARENA = WS_XB + 64 * MiB;
constexpr size_t WS_ACT = WS_ARENA;
constexpr size_t WS_UCAT = WS_ARENA;
constexpr size_t WS_ZPC = WS_UCAT + 30 * MiB;
constexpr size_t WS_Q = WS_ZPC;
constexpr size_t WS_YG = WS_ZPC + 64 * MiB;
constexpr size_t WS_YMIX = WS_YG + 24 * MiB;
constexpr size_t WS_XLOC = WS_YMIX + 64 * MiB;
constexpr size_t WS_KV = WS_ARENA + 194 * MiB;
constexpr size_t WS_MEMB = WS_KV + 32 * MiB;
constexpr size_t WS_RSMEM = WS_MEMB + 8 * MiB;
constexpr size_t WS_SSQ = WS_RSMEM + 1 * MiB;
constexpr size_t WS_END = WS_SSQ + 2 * MiB;
static_assert(WS_ACT + (size_t)M * DFF * 2 <= WS_KV && WS_XLOC + (size_t)GROWS * 128 * 4 <= WS_KV && WS_UCAT + (size_t)GROWS * KCAT * 2 <= WS_ZPC && (size_t)NGR * NTOK * KCAT * 2 <= 54 * MiB, "arena");
static_assert(WS_END <= 500 * MiB, "ws");

__host__ __device__ __forceinline__ int lds_byte(int r, int c) { const int st = (r >> 4) * 2 + (c >> 5), rr = r & 15, cc = c & 31, ob = rr * 64 + cc * 2; return st * 1024 + (ob ^ (((ob >> 9) & 1) << 5)); }
__host__ __device__ __forceinline__ void stage_rc(int b, int& R, int& C) { const int st = b / 1024, sb = b % 1024, swz = sb ^ (((sb >> 9) & 1) << 5); R = (st >> 1) * 16 + swz / 64; C = (st & 1) * 32 + (swz % 64) / 2; }
__host__ __device__ __forceinline__ int perm32(int rho) { const int n = rho >> 4, i = rho & 15; return 8 * (i >> 2) + 4 * n + (i & 3); }

struct Unit { int pm, pn, kind, nt; size_t aoff, boff; };
struct Gemm { const unsigned char* A; const unsigned char* Bt; int lda, ldb, K; int a_blocked, b_blocked; };

struct Sched {
    int nM, nN, nwg, G, c, kv, bdiv, causal;
    size_t a0, aM, aN, b0, bM, bN;
    size_t kv_memb, kv_wk0, kv_wk1, kv_wv0, kv_wv1;
    __device__ __forceinline__ void init(int nM_, int nN_, int G_, int c_) { nM = nM_; nN = nN_; nwg = nM * nN; G = G_; c = c_; kv = 0; bdiv = 1; causal = 0; a0 = aM = aN = b0 = bM = bN = 0; kv_memb = kv_wk0 = kv_wk1 = kv_wv0 = kv_wv1 = 0; }
    __device__ __forceinline__ bool next(int i, Unit& u) const {
        const long L = (long)i * G + c; if (L >= nwg) return false;
        if (kv) {
            const int sub = (int)L >> 6, r = (int)L & 63; u.kind = sub; u.nt = 0;
            if ((sub & 1) == 0) { u.pm = r >> 2; u.pn = r & 3; u.aoff = kv_memb + (size_t)u.pm * 524288; u.boff = (sub ? kv_wk1 : kv_wk0) + (size_t)u.pn * 524288; }
            else { u.pm = r >> 4; u.pn = r & 15; u.aoff = (sub == 3 ? kv_wv1 : kv_wv0) + (size_t)u.pm * 524288; u.boff = kv_memb + (size_t)u.pn * 524288; }
            return true;
        }
        int wgid = (int)L; { const int q = nwg / NXCD, r = nwg % NXCD, xcd = wgid % NXCD, off = wgid / NXCD; wgid = (xcd < r ? xcd * (q + 1) : r * (q + 1) + (xcd - r) * q) + off; }
        const int nig = WGM * nN, gid = wgid / nig, fm = gid * WGM, gsz = (nM - fm) < WGM ? (nM - fm) : WGM;
        u.pm = fm + ((wgid % nig) % gsz); u.pn = (wgid % nig) / gsz; u.kind = 0; u.nt = causal ? 2 + 4 * (u.pn + 1) : 0;
        u.aoff = a0 + (size_t)u.pm * aM + (size_t)u.pn * aN; u.boff = b0 + (size_t)u.pn * bN + (size_t)(u.pm / bdiv) * bM;
        return true;
    }
};

__device__ __forceinline__ unsigned cvt_pk_bf16(float lo, float hi) { unsigned r; asm volatile("v_cvt_pk_bf16_f32 %0, %1, %2" : "=v"(r) : "v"(lo), "v"(hi)); return r; }
__device__ __forceinline__ float bf_lo(unsigned w) { return __uint_as_float(w << 16); }
__device__ __forceinline__ float bf_hi(unsigned w) { return __uint_as_float(w & 0xffff0000u); }
__device__ __forceinline__ float fsigm(float v) { return __builtin_amdgcn_rcpf(1.f + __builtin_amdgcn_exp2f(-1.4426950408889634f * v)); }
__device__ __forceinline__ float gelu_tanh(float v) { return v * fsigm(1.5957691216057308f * (v + 0.044715f * v * v * v)); }
__device__ __forceinline__ u32x4 pack8(f32x4 a, f32x4 b) { u32x4 w; w.x = cvt_pk_bf16(a[0], a[1]); w.y = cvt_pk_bf16(a[2], a[3]); w.z = cvt_pk_bf16(b[0], b[1]); w.w = cvt_pk_bf16(b[2], b[3]); return w; }
__device__ __forceinline__ void unpack8(u32x4 w, f32x4& a, f32x4& b) { a = (f32x4){bf_lo(w.x), bf_hi(w.x), bf_lo(w.y), bf_hi(w.y)}; b = (f32x4){bf_lo(w.z), bf_hi(w.z), bf_lo(w.w), bf_hi(w.w)}; }

__device__ __forceinline__ void load_rstd(const float* ssq, int rowbase, int fq, float (&rs)[2][4]) {
#pragma unroll
    for (int ai = 0; ai < 2; ++ai)
#pragma unroll
        for (int m = 0; m < 4; ++m) {
            const f32x4 v = *(const f32x4*)(ssq + (size_t)(rowbase + ai * HALF + m * 16) * 16 + fq * 4);
            float s = (v[0] + v[1]) + (v[2] + v[3]); s += __shfl_xor(s, 16); s += __shfl_xor(s, 32);
            rs[ai][m] = rsqrtf(s * (1.f / D) + EPS);
        }
}

struct EpiSwiglu {
    static constexpr bool PERM = true, SYNC = false; static constexpr int NST = 8;
    bf16_t* O; const float* ssq;
    __device__ __forceinline__ void operator()(f32x4 (&acc)[2][2][4][2], const Unit& u, int wr, int wc, int fr, int fq, LAS unsigned char*) const {
        const int row0 = u.pm * BM + wr * 64 + fr, col0 = u.pn * 128 + wc * 32 + 8 * fq;
        float rs[2][4]; load_rstd(ssq, row0, fq, rs);
#pragma unroll
        for (int ai = 0; ai < 2; ++ai)
#pragma unroll
            for (int m = 0; m < 4; ++m) {
                const f32x2 r2 = {rs[ai][m], rs[ai][m]};
                unsigned w[4];
#pragma unroll
                for (int q = 0; q < 4; ++q) {
                    const f32x4 ag = acc[ai][0][m][q >> 1], au = acc[ai][1][m][q >> 1];
                    const f32x2 g = (q & 1) ? (f32x2){ag[2], ag[3]} * r2 : (f32x2){ag[0], ag[1]} * r2;
                    const f32x2 up = (q & 1) ? (f32x2){au[2], au[3]} * r2 : (f32x2){au[0], au[1]} * r2;
                    const f32x2 t = g * (-1.4426950408889634f);
                    f32x2 d; d.x = __builtin_amdgcn_exp2f(t.x); d.y = __builtin_amdgcn_exp2f(t.y);
                    d = d + 1.0f;
                    f32x2 inv; inv.x = __builtin_amdgcn_rcpf(d.x); inv.y = __builtin_amdgcn_rcpf(d.y);
                    const f32x2 h = (g * up) * inv;
                    w[q] = cvt_pk_bf16(h.x, h.y);
                }
                __builtin_nontemporal_store((u32x4){w[0], w[1], w[2], w[3]}, (u32x4*)(O + (size_t)u.pm * BM * DFF + (size_t)(col0 >> 6) * (BM * BK) + (size_t)(wr * 64 + fr + ai * HALF + m * 16) * BK + (col0 & 63)));
                asm volatile("" ::: "memory");
            }
    }
};
struct EpiResid {
    static constexpr bool PERM = true, SYNC = false; static constexpr int NST = 16;
    bf16_t* xb; float* ssq; float alpha;
    __device__ __forceinline__ void operator()(f32x4 (&acc)[2][2][4][2], const Unit& u, int wr, int wc, int fr, int fq, LAS unsigned char*) const {
        const int row0 = u.pm * BM + wr * 64 + fr, col0 = u.pn * BM + wc * 32 + 8 * fq;
#pragma unroll
        for (int ai = 0; ai < 2; ++ai) {
            u32x4 xo[4][2];
#pragma unroll
            for (int m = 0; m < 4; ++m)
#pragma unroll
                for (int bj = 0; bj < 2; ++bj) xo[m][bj] = *(const u32x4*)(xb + (size_t)(row0 + ai * HALF + m * 16) * D + col0 + bj * HALF);
#pragma unroll
            for (int m = 0; m < 4; ++m) {
                const int row = row0 + ai * HALF + m * 16; float s = 0.f;
#pragma unroll
                for (int bj = 0; bj < 2; ++bj) {
                    f32x4 x0, x1; unpack8(xo[m][bj], x0, x1);
                    const u32x4 w = pack8(x0 + acc[ai][bj][m][0] * alpha, x1 + acc[ai][bj][m][1] * alpha);
                    *(u32x4*)(xb + (size_t)row * D + col0 + bj * HALF) = w;
                    unpack8(w, x0, x1);
                    s += ((x0[0] * x0[0] + x0[1] * x0[1]) + (x0[2] * x0[2] + x0[3] * x0[3])) + ((x1[0] * x1[0] + x1[1] * x1[1]) + (x1[2] * x1[2] + x1[3] * x1[3]));
                }
                s += __shfl_xor(s, 16); s += __shfl_xor(s, 32);
                if (fq == 0) ssq[(size_t)row * 16 + u.pn * 4 + wc] = s;
            }
            asm volatile("" ::: "memory");
        }
    }
};
struct EpiRowScale {
    static constexpr bool PERM = true, SYNC = false; static constexpr int NST = 16;
    bf16_t* O; int ldc; const float* ssq;
    __device__ __forceinline__ void operator()(f32x4 (&acc)[2][2][4][2], const Unit& u, int wr, int wc, int fr, int fq, LAS unsigned char*) const {
        const int row0 = u.pm * BM + wr * 64 + fr, col0 = u.pn * BM + wc * 32 + 8 * fq;
        float rs[2][4];
        if (ssq) load_rstd(ssq, row0, fq, rs);
        else {
#pragma unroll
            for (int ai = 0; ai < 2; ++ai)
#pragma unroll
                for (int m = 0; m < 4; ++m) rs[ai][m] = 1.f; }
#pragma unroll
        for (int ai = 0; ai < 2; ++ai)
#pragma unroll
            for (int m = 0; m < 4; ++m) { bf16_t* rowp = O + (size_t)(row0 + ai * HALF + m * 16) * ldc + col0;
#pragma unroll
                for (int bj = 0; bj < 2; ++bj) *(u32x4*)(rowp + bj * HALF) = pack8(acc[ai][bj][m][0] * rs[ai][m], acc[ai][bj][m][1] * rs[ai][m]);
                asm volatile("" ::: "memory"); }
    }
};
struct EpiWin {
    static constexpr bool PERM = true, SYNC = false; static constexpr int NST = 0;
    bf16_t* ucat; bf16_t* zpc; const float* ssq;
    __device__ __forceinline__ void operator()(f32x4 (&acc)[2][2][4][2], const Unit& u, int wr, int wc, int fr, int fq, LAS unsigned char*) const {
        const int row0 = u.pm * BM + wr * 64 + fr, col0 = u.pn * BM + wc * 32 + 8 * fq;
        float rs[2][4]; load_rstd(ssq, row0, fq, rs);
#pragma unroll
        for (int ai = 0; ai < 2; ++ai)
#pragma unroll
            for (int m = 0; m < 4; ++m) { const int row = row0 + ai * HALF + m * 16;
#pragma unroll
                for (int bj = 0; bj < 2; ++bj) {
                    const int col = col0 + bj * HALF;
                    const u32x4 w = pack8(acc[ai][bj][m][0] * rs[ai][m], acc[ai][bj][m][1] * rs[ai][m]);
                    if (col < DSSM) { const int g = col >> 4, i0 = col & 15; *(u32x4*)(ucat + ((size_t)(g * NCH + row / CH) * KCAT + 128 + (row % CH) * 16 + i0)) = w; }
                    else if (col < DIN) *(u32x4*)(zpc + (size_t)row * D + (col - DSSM)) = w;
                }
                asm volatile("" ::: "memory"); }
    }
};
struct EpiKV {
    static constexpr bool PERM = true, SYNC = false; static constexpr int NST = 0;
    bf16_t* kb; bf16_t* vt; const float* rsmem;
    __device__ __forceinline__ void operator()(f32x4 (&acc)[2][2][4][2], const Unit& u, int wr, int wc, int fr, int fq, LAS unsigned char*) const {
        const int row0 = u.pm * BM + wr * 64 + fr, col0 = u.pn * BM + wc * 32 + 8 * fq, l = u.kind >> 1;
        if ((u.kind & 1) == 0) {
            bf16_t* O = kb + (size_t)l * MM * D;
#pragma unroll
            for (int ai = 0; ai < 2; ++ai)
#pragma unroll
                for (int m = 0; m < 4; ++m) { const int row = row0 + ai * HALF + m * 16; const float r = rsmem[row];
#pragma unroll
                    for (int bj = 0; bj < 2; ++bj) *(u32x4*)(O + (size_t)row * D + col0 + bj * HALF) = pack8(acc[ai][bj][m][0] * r, acc[ai][bj][m][1] * r);
                    asm volatile("" ::: "memory"); }
        } else {
            bf16_t* O = vt + (size_t)l * MM * D;
            f32x4 cs[2][2];
#pragma unroll
            for (int bj = 0; bj < 2; ++bj)
#pragma unroll
                for (int n = 0; n < 2; ++n) cs[bj][n] = *(const f32x4*)(rsmem + col0 + bj * HALF + 4 * n);
#pragma unroll
            for (int ai = 0; ai < 2; ++ai)
#pragma unroll
                for (int m = 0; m < 4; ++m) { const int row = row0 + ai * HALF + m * 16;
#pragma unroll
                    for (int bj = 0; bj < 2; ++bj) *(u32x4*)(O + (size_t)row * MM + col0 + bj * HALF) = pack8(acc[ai][bj][m][0] * cs[bj][0], acc[ai][bj][m][1] * cs[bj][1]);
                    asm volatile("" ::: "memory"); }
        }
    }
};
struct EpiXloc {
    static constexpr bool PERM = false, SYNC = false; static constexpr int NST = 0;
    float* xloc;
    __device__ __forceinline__ void operator()(f32x4 (&acc)[2][2][4][2], const Unit& u, int wr, int wc, int fr, int fq, LAS unsigned char*) const {
        const int row0 = u.pm * BM + wr * 64 + fr, col0 = wc * 32 + 4 * fq;
#pragma unroll
        for (int ai = 0; ai < 2; ++ai)
#pragma unroll
            for (int m = 0; m < 4; ++m)
#pragma unroll
                for (int n = 0; n < 2; ++n) *(f32x4*)(xloc + (size_t)(row0 + ai * HALF + m * 16) * 128 + col0 + n * 16) = acc[ai][0][m][n];
    }
};
struct EpiS5 {
    static constexpr bool PERM = true, SYNC = false; static constexpr int NST = 16;
    const bf16_t* ucat; bf16_t* yg; const float* dvec;
    __device__ __forceinline__ void operator()(f32x4 (&acc)[2][2][4][2], const Unit& u, int wr, int wc, int fr, int fq, LAS unsigned char*) const {
        const int row0 = u.pm * BM + wr * 64 + fr, col0 = u.pn * BM + wc * 32 + 8 * fq, g = u.pm / (NCH / BM);
        const int o0 = col0 & 15;
        const f32x4 d0 = *(const f32x4*)(dvec + g * SG + o0), d1 = *(const f32x4*)(dvec + g * SG + o0 + 4);
#pragma unroll
        for (int ai = 0; ai < 2; ++ai) {
            u32x4 uv[4][2];
#pragma unroll
            for (int m = 0; m < 4; ++m)
#pragma unroll
                for (int bj = 0; bj < 2; ++bj) uv[m][bj] = *(const u32x4*)(ucat + (size_t)(row0 + ai * HALF + m * 16) * KCAT + 128 + col0 + bj * HALF);
#pragma unroll
            for (int m = 0; m < 4; ++m) { const int row = row0 + ai * HALF + m * 16, chunk = row & (NCH - 1);
#pragma unroll
                for (int bj = 0; bj < 2; ++bj) {
                    const int col = col0 + bj * HALF, t = col >> 4;
                    f32x4 u0, u1; unpack8(uv[m][bj], u0, u1);
                    f32x4 y0 = acc[ai][bj][m][0] + d0 * u0, y1 = acc[ai][bj][m][1] + d1 * u1;
#pragma unroll
                    for (int e = 0; e < 4; ++e) { y0[e] = gelu_tanh(y0[e]); y1[e] = gelu_tanh(y1[e]); }
                    *(u32x4*)(yg + (size_t)(chunk * CH + t) * DSSM + g * SG + o0) = pack8(y0, y1);
                } }
            asm volatile("" ::: "memory");
        }
    }
};
struct EpiGlu {
    static constexpr bool PERM = true, SYNC = false; static constexpr int NST = 0;
    const bf16_t* yg; bf16_t* ymix;
    __device__ __forceinline__ void operator()(f32x4 (&acc)[2][2][4][2], const Unit& u, int wr, int wc, int fr, int fq, LAS unsigned char*) const {
        const int row0 = u.pm * BM + wr * 64 + fr, col0 = u.pn * BM + wc * 32 + 8 * fq;
#pragma unroll
        for (int ai = 0; ai < 2; ++ai) {
            u32x4 yv[4][2];
#pragma unroll
            for (int m = 0; m < 4; ++m)
#pragma unroll
                for (int bj = 0; bj < 2; ++bj) { const int col = col0 + bj * HALF; yv[m][bj] = (col < DSSM) ? *(const u32x4*)(yg + (size_t)(row0 + ai * HALF + m * 16) * DSSM + col) : (u32x4){0u, 0u, 0u, 0u}; }
#pragma unroll
            for (int m = 0; m < 4; ++m) { const int row = row0 + ai * HALF + m * 16;
#pragma unroll
                for (int bj = 0; bj < 2; ++bj) {
                    const int col = col0 + bj * HALF;
                    if (col < DSSM) {
                        f32x4 y0, y1; unpack8(yv[m][bj], y0, y1);
                        f32x4 a = acc[ai][bj][m][0], b = acc[ai][bj][m][1];
#pragma unroll
                        for (int e = 0; e < 4; ++e) { a[e] = y0[e] * fsigm(a[e]); b[e] = y1[e] * fsigm(b[e]); }
                        *(u32x4*)(ymix + (size_t)row * D + col) = pack8(a, b);
                    } } }
            asm volatile("" ::: "memory");
        }
    }
};
struct EpiSoftmax {
    static constexpr bool PERM = true, SYNC = true; static constexpr int NST = 16;
    bf16_t* O;
    __device__ __forceinline__ void operator()(f32x4 (&acc)[2][2][4][2], const Unit& u, int wr, int wc, int fr, int fq, LAS unsigned char* xch) const {
        LAS float* Lmax = (LAS float*)xch; LAS float* Lsum = Lmax + 1024;
        const float sc = 0.0625f * 1.4426950408889634f;
#pragma unroll
        for (int ai = 0; ai < 2; ++ai)
#pragma unroll
            for (int m = 0; m < 4; ++m) {
                float mx = -3.0e38f;
#pragma unroll
                for (int bj = 0; bj < 2; ++bj)
#pragma unroll
                    for (int n = 0; n < 2; ++n) { acc[ai][bj][m][n] = acc[ai][bj][m][n] * sc; const f32x4 v = acc[ai][bj][m][n]; mx = fmaxf(mx, fmaxf(fmaxf(v[0], v[1]), fmaxf(v[2], v[3]))); }
                mx = fmaxf(mx, __shfl_xor(mx, 16)); mx = fmaxf(mx, __shfl_xor(mx, 32));
                if (fq == 0) Lmax[(ai * HALF + wr * 64 + m * 16 + fr) * 4 + wc] = mx;
                asm volatile("" ::: "memory");
            }
        asm volatile("s_waitcnt lgkmcnt(0)" ::: "memory"); __builtin_amdgcn_s_barrier(); asm volatile("" ::: "memory");
#pragma unroll
        for (int ai = 0; ai < 2; ++ai)
#pragma unroll
            for (int m = 0; m < 4; ++m) {
                const f32x4 mv = *(const LAS f32x4*)(Lmax + (ai * HALF + wr * 64 + m * 16 + fr) * 4);
                const float mx = fmaxf(fmaxf(mv[0], mv[1]), fmaxf(mv[2], mv[3])); float s = 0.f;
#pragma unroll
                for (int bj = 0; bj < 2; ++bj)
#pragma unroll
                    for (int n = 0; n < 2; ++n) { f32x4 v = acc[ai][bj][m][n];
#pragma unroll
                        for (int e = 0; e < 4; ++e) { v[e] = __builtin_amdgcn_exp2f(v[e] - mx); s += v[e]; }
                        acc[ai][bj][m][n] = v; }
                s += __shfl_xor(s, 16); s += __shfl_xor(s, 32);
                if (fq == 0) Lsum[(ai * HALF + wr * 64 + m * 16 + fr) * 4 + wc] = s;
                asm volatile("" ::: "memory");
            }
        asm volatile("s_waitcnt lgkmcnt(0)" ::: "memory"); __builtin_amdgcn_s_barrier(); asm volatile("" ::: "memory");
        const int row0 = u.pm * BM + wr * 64 + fr, col0 = u.pn * BM + wc * 32 + 8 * fq;
#pragma unroll
        for (int ai = 0; ai < 2; ++ai)
#pragma unroll
            for (int m = 0; m < 4; ++m) {
                const f32x4 sv = *(const LAS f32x4*)(Lsum + (ai * HALF + wr * 64 + m * 16 + fr) * 4);
                const float inv = 1.f / ((sv[0] + sv[1]) + (sv[2] + sv[3]));
                bf16_t* rowp = O + (size_t)(row0 + ai * HALF + m * 16) * D + col0;
#pragma unroll
                for (int bj = 0; bj < 2; ++bj) *(u32x4*)(rowp + bj * HALF) = pack8(acc[ai][bj][m][0] * inv, acc[ai][bj][m][1] * inv);
                asm volatile("" ::: "memory");
            }
    }
};

template <class Epi, class SchedT>
__device__ __forceinline__ void gemm_phase(LAS unsigned char* lds, const Gemm g, const SchedT& S, const Epi& E) {
    int tid_ = threadIdx.x; asm volatile("" : "+v"(tid_));
    const int tid = tid_, wid = __builtin_amdgcn_readfirstlane(tid >> 6), lane = tid & 63, wr = wid >> 2, wc = wid & 3, fr = lane & 15, fq = lane >> 4;
    int nt_ = g.K / BK; asm volatile("" : "+s"(nt_)); const int ntK = nt_;
    unsigned voffA[2], voffB[2];
#pragma unroll
    for (int i = 0; i < 2; ++i) { int R, C; stage_rc(tid * 16 + i * 8192, R, C); const int Rb = Epi::PERM ? ((R & ~31) + perm32(R & 31)) : R;
        voffA[i] = g.a_blocked ? (unsigned)(R * BK + C) * 2u : (unsigned)(R * g.lda + C) * 2u; voffB[i] = g.b_blocked ? (unsigned)(Rb * BK + C) * 2u : (unsigned)(Rb * g.ldb + C) * 2u; }
    const size_t kstep = (size_t)(BK * 2), kstepA = g.a_blocked ? (size_t)(BM * BK * 2) : kstep, kstepB = g.b_blocked ? (size_t)(BM * BK * 2) : kstep;
    const size_t hstepA = g.a_blocked ? (size_t)(HALF * BK * 2) : (size_t)HALF * g.lda * 2, hstepB = g.b_blocked ? (size_t)(HALF * BK * 2) : (size_t)HALF * g.ldb * 2;
    const unsigned ldsw = (unsigned)wid * 1024u;
    const int aoff = lds_byte(wr * 64 + fr, fq * 8), boff = lds_byte(wc * 32 + fr, fq * 8);
#define PG8_SA(b, h) (((b) * 2 + (h)) * HTB)
#define PG8_SB(b, h) ((4 + (b) * 2 + (h)) * HTB)
#define PG8_STAGE(bufoff, gbase, voff) do { _Pragma("unroll") for (int _i = 0; _i < 2; ++_i) \
        __builtin_amdgcn_global_load_lds((const unsigned*)((const char*)(gbase) + (voff)[_i]), (LAS unsigned*)(lds + (bufoff) + ldsw + _i * 8192), 16, 0, 0); } while (0)
#define PG8_LDA(dst, b, h) do { _Pragma("unroll") for (int m = 0; m < 4; ++m) _Pragma("unroll") for (int k = 0; k < 2; ++k) dst[m][k] = *(const LAS bf16x8*)(lds + PG8_SA(b, h) + aoff + m * 2048 + k * 1024); } while (0)
#define PG8_LDB(dst, b, h) do { _Pragma("unroll") for (int n = 0; n < 2; ++n) _Pragma("unroll") for (int k = 0; k < 2; ++k) dst[n][k] = *(const LAS bf16x8*)(lds + PG8_SB(b, h) + boff + n * 2048 + k * 1024); } while (0)
#define PG8_MMA(ai, bj, At, Bt) do { __builtin_amdgcn_s_setprio(1); _Pragma("unroll") for (int m = 0; m < 4; ++m) _Pragma("unroll") for (int n = 0; n < 2; ++n) _Pragma("unroll") for (int k = 0; k < 2; ++k) \
        acc[ai][bj][m][n] = __builtin_amdgcn_mfma_f32_16x16x32_bf16(Bt[n][k], At[m][k], acc[ai][bj][m][n], 0, 0, 0); __builtin_amdgcn_s_setprio(0); } while (0)
#define PG8_WAIT_V(n) asm volatile("s_waitcnt vmcnt(" #n ")" ::: "memory")
#define PG8_WAIT_L(n) asm volatile("s_waitcnt lgkmcnt(" #n ")" ::: "memory")
#define PG8_BAR __builtin_amdgcn_s_barrier()
#define PG8_SCHED __builtin_amdgcn_sched_barrier(0)
    Unit cur, nxt; int ui = 0;
    if (!S.next(0, cur)) return;
    f32x4 acc[2][2][4][2];
#pragma unroll
    for (int a = 0; a < 2; ++a)
#pragma unroll
        for (int b = 0; b < 2; ++b)
#pragma unroll
            for (int m = 0; m < 4; ++m)
#pragma unroll
                for (int n = 0; n < 2; ++n) acc[a][b][m][n] = (f32x4){0.f, 0.f, 0.f, 0.f};
    bf16x8 At[4][2], B0[2][2], B1[2][2];
    const char* cA = (const char*)g.A + cur.aoff; const char* cB = (const char*)g.Bt + cur.boff;
    PG8_STAGE(PG8_SB(0, 0), cB, voffB); PG8_STAGE(PG8_SB(0, 1), cB + hstepB, voffB); PG8_STAGE(PG8_SA(0, 0), cA, voffA); PG8_STAGE(PG8_SA(0, 1), cA + hstepA, voffA);
    if (wr == 1) PG8_BAR;
    PG8_WAIT_V(2); PG8_BAR;
    PG8_STAGE(PG8_SB(1, 0), cB + kstepB, voffB); PG8_STAGE(PG8_SA(1, 0), cA + kstepA, voffA); PG8_STAGE(PG8_SB(1, 1), cB + hstepB + kstepB, voffB);
    PG8_WAIT_V(6); PG8_BAR;
    for (;;) {
        const int nt = cur.nt ? cur.nt : ntK;
        const bool has_next = S.next(ui + 1, nxt);
        const char* nA = has_next ? (const char*)g.A + nxt.aoff : cA; const char* nB = has_next ? (const char*)g.Bt + nxt.boff : cB;
        for (int t = 0; t < nt; t += 2) {
            const bool last = (t == nt - 2);
            const char* a1 = cA + (size_t)(t + 1) * kstepA;
            const char* a2 = last ? nA : cA + (size_t)(t + 2) * kstepA; const char* b2 = last ? nB : cB + (size_t)(t + 2) * kstepB;
            const char* a3 = a2 + kstepA; const char* b3 = b2 + kstepB;
            PG8_LDB(B0, 0, 0); PG8_LDB(B1, 0, 1); PG8_SCHED; PG8_LDA(At, 0, 0); PG8_STAGE(PG8_SA(1, 1), a1 + hstepA, voffA);
            PG8_WAIT_V(8); PG8_WAIT_L(0); PG8_BAR; PG8_MMA(0, 0, At, B0); PG8_MMA(0, 1, At, B1); PG8_BAR; PG8_SCHED;
            PG8_LDA(At, 0, 1); PG8_STAGE(PG8_SB(0, 0), b2, voffB); PG8_STAGE(PG8_SB(0, 1), b2 + hstepB, voffB); PG8_STAGE(PG8_SA(0, 0), a2, voffA);
            PG8_WAIT_V(8); PG8_WAIT_L(0); PG8_BAR; PG8_MMA(1, 0, At, B0); PG8_MMA(1, 1, At, B1); PG8_BAR; PG8_SCHED;
            PG8_LDB(B0, 1, 0); PG8_LDB(B1, 1, 1); PG8_SCHED; PG8_LDA(At, 1, 0); PG8_STAGE(PG8_SA(0, 1), a2 + hstepA, voffA);
            PG8_WAIT_V(8); PG8_WAIT_L(0); PG8_BAR; PG8_MMA(0, 0, At, B0); PG8_MMA(0, 1, At, B1); PG8_BAR; PG8_SCHED;
            PG8_LDA(At, 1, 1); PG8_STAGE(PG8_SB(1, 0), b3, voffB); PG8_STAGE(PG8_SB(1, 1), b3 + hstepB, voffB); PG8_STAGE(PG8_SA(1, 0), a3, voffA);
            PG8_WAIT_V(8); PG8_WAIT_L(0); PG8_BAR; PG8_MMA(1, 0, At, B0); PG8_MMA(1, 1, At, B1); PG8_BAR; PG8_SCHED;
        }
        if (wr == 0) PG8_BAR;
        E(acc, cur, wr, wc, fr, fq, lds + XCH_OFF);
        if (!has_next) break;
#pragma unroll
        for (int a = 0; a < 2; ++a)
#pragma unroll
            for (int b = 0; b < 2; ++b)
#pragma unroll
                for (int m = 0; m < 4; ++m)
#pragma unroll
                    for (int n = 0; n < 2; ++n) acc[a][b][m][n] = (f32x4){0.f, 0.f, 0.f, 0.f};
        cur = nxt; cA = nA; cB = nB; ++ui;
        if (wr == 1) PG8_BAR;
    }
    PG8_WAIT_V(0);
    PG8_BAR;
#undef PG8_SA
#undef PG8_SB
#undef PG8_STAGE
#undef PG8_LDA
#undef PG8_LDB
#undef PG8_MMA
#undef PG8_WAIT_V
#undef PG8_WAIT_L
#undef PG8_BAR
#undef PG8_SCHED
}
#define XB_TMO      128
#define XB_XCNT(j)  (256  + 64 * (j))
#define XB_XSUB(j)  (1280 + 64 * (j))
#define XB_XGEN(j)  (2304 + 64 * (j))
#define XB_TOP      3328
#define XB_TOPGEN   3392
#define XCD_BAR_WORDS 3456
#define XB_SPIN_CAP (1u << 20)
__device__ __forceinline__ unsigned xb_ld(unsigned* p)              { return __hip_atomic_load(p, __ATOMIC_RELAXED, __HIP_MEMORY_SCOPE_AGENT); }
__device__ __forceinline__ unsigned xb_add(unsigned* p, unsigned v) { return __hip_atomic_fetch_add(p, v, __ATOMIC_RELAXED, __HIP_MEMORY_SCOPE_AGENT); }
__device__ __forceinline__ unsigned xb_xcc_id() { return (unsigned)__builtin_amdgcn_s_getreg((3 << 11) | 20) & 0xFu; }
#define XB_SPIN(cond, bar) do { unsigned _sp = 0; while (cond) { __builtin_amdgcn_s_sleep(1); \
    if ((++_sp & 255u) == 0u) { if (xb_ld(&(bar)[XB_TMO])) break; if (_sp > XB_SPIN_CAP) { atomicAdd(&(bar)[XB_TMO], 1u); break; } } } } while (0)
struct XcdBarrier { unsigned* bar; unsigned x; volatile LAS unsigned* st; };
__device__ __forceinline__ XcdBarrier xcd_barrier_post(unsigned* bar, volatile LAS unsigned* st) {
    XcdBarrier b; b.bar = bar; b.x = xb_xcc_id(); b.st = st;
    if (threadIdx.x == 0) (void)xb_add(&bar[XB_XCNT(b.x)], 1u);
    return b;
}
__device__ __forceinline__ void xcd_barrier_complete(unsigned* bar, unsigned x, unsigned& nloc, unsigned& nx) {
    const unsigned G = gridDim.x * gridDim.y * gridDim.z;
    unsigned sum, cnt, mine, sp = 0u;
    for (;;) {
        sum = 0u; cnt = 0u; mine = 0u;
#pragma unroll
        for (unsigned j = 0; j < 16; ++j) { const unsigned c = xb_ld(&bar[XB_XCNT(j)]); sum += c; cnt += (c > 0u) ? 1u : 0u; mine = (j == x) ? c : mine; }
        if (sum == G) break;
        __builtin_amdgcn_s_sleep(1);
        if ((++sp & 255u) == 0u) { if (xb_ld(&bar[XB_TMO])) break; if (sp > XB_SPIN_CAP) { atomicAdd(&bar[XB_TMO], 1u); break; } }
    }
    nloc = mine > 0u ? mine : 1u; nx = cnt > 0u ? cnt : 1u;
}
__device__ __forceinline__ void xcd_barrier(const XcdBarrier& b) {
    asm volatile("s_waitcnt vmcnt(0)" ::: "memory");
    __syncthreads();
    if (threadIdx.x == 0) {
        unsigned* bar = b.bar;
        __builtin_amdgcn_s_waitcnt(0);
        unsigned nloc = b.st[0], nx = b.st[1];
        if (nloc == 0u) { xcd_barrier_complete(bar, b.x, nloc, nx); b.st[0] = nloc; b.st[1] = nx; }
        const unsigned old = xb_add(&bar[XB_XSUB(b.x)], 1u);
        const unsigned gen = old / nloc;
        if (old + 1u == (gen + 1u) * nloc) {
            __builtin_amdgcn_fence(__ATOMIC_RELEASE, "agent");
            asm volatile("s_waitcnt vmcnt(0)" ::: "memory");
            const unsigned og = xb_add(&bar[XB_TOP], 1u);
            const unsigned tg = og / nx;
            if (og + 1u == (tg + 1u) * nx) xb_add(&bar[XB_TOPGEN], 1u);
            else XB_SPIN(xb_ld(&bar[XB_TOPGEN]) == tg, bar);
            __builtin_amdgcn_fence(__ATOMIC_ACQUIRE, "agent");
            xb_add(&bar[XB_XGEN(b.x)], 1u);
            asm volatile("s_waitcnt vmcnt(0)" ::: "memory");
        } else {
            XB_SPIN(xb_ld(&bar[XB_XGEN(b.x)]) == gen, bar);
            __builtin_amdgcn_fence(__ATOMIC_ACQUIRE, "agent");
            asm volatile("s_waitcnt vmcnt(0)" ::: "memory");
        }
    }
    __syncthreads();
}

__device__ __forceinline__ float wave_sum(float v) {
#pragma unroll
    for (int o = 1; o < 64; o <<= 1) v += __shfl_xor(v, o);
    return v;
}
#define LDS_WAIT() asm volatile("s_waitcnt lgkmcnt(0)" ::: "memory")
__device__ __forceinline__ void lam_pow(float lr, float li, float dt, float k, float& pr, float& pi) {
    const float mag = __expf(lr * dt * k);
    const float rev = __builtin_amdgcn_fractf(li * dt * 0.15915494309189535f * k);
    pr = mag * __builtin_amdgcn_cosf(rev); pi = mag * __builtin_amdgcn_sinf(rev);
}
__device__ __forceinline__ void zcoef(float lr, float li, float dt, float& zr, float& zi) {
    const float mag = expf(lr * dt), ar = mag * cosf(li * dt), ai = mag * sinf(li * dt), den = lr * lr + li * li;
    zr = ((ar - 1.f) * lr + ai * li) / den; zi = (ai * lr - (ar - 1.f) * li) / den;
}

struct Args { const float* in[35]; float* out; unsigned char* ws; int ph_lo, ph_hi; };
typedef const Args __attribute__((address_space(4)))* KArgs;
__device__ __forceinline__ KArgs kargs() { unsigned long v = (unsigned long)__builtin_amdgcn_kernarg_segment_ptr(); asm volatile("" : "+s"(v)); return (KArgs)v; }
enum { I_X = 0, I_MEM, I_F1N, I_F1G, I_F1U, I_F1D, I_MIXN, I_WIN, I_WOUT, I_LRE, I_LIM, I_LDT, I_BRE, I_BIM, I_CRE, I_CIM, I_SD, I_WGLU, I_PW, I_PS, I_CW, I_CB, I_LNG, I_LNB,
       I_XN, I_MN, I_WQ, I_WK, I_WV, I_WO, I_F2N, I_F2G, I_F2U, I_F2D, I_FN };

__device__ __forceinline__ void tr_load(const float* W, int ldw, const float* gain, int k0, int n0, int lane, float (&v)[32]) {
#pragma unroll
    for (int i = 0; i < 32; ++i) { const int kk = 2 * i + (lane >> 5); v[i] = __builtin_nontemporal_load(W + (size_t)(k0 + kk) * ldw + n0 + (lane & 31)); }
    if (gain) {
#pragma unroll
        for (int i = 0; i < 32; ++i) v[i] *= gain[k0 + 2 * i + (lane >> 5)]; }
}
__device__ __forceinline__ void tr_store(const float (&v)[32], bf16_t* WT, int ldt, int k0, int drow0, LAS float* scr, int lane, int blk) {
#pragma unroll
    for (int i = 0; i < 32; ++i) scr[(2 * i + (lane >> 5)) * 33 + (lane & 31)] = v[i];
    LDS_WAIT(); asm volatile("" ::: "memory");
    const int c = lane & 7;
#pragma unroll
    for (int j = 0; j < 4; ++j) { const int n = (lane >> 3) + 8 * j; const LAS float* s = scr + (8 * c) * 33 + n;
        u32x4 o; o.x = cvt_pk_bf16(s[0 * 33], s[1 * 33]); o.y = cvt_pk_bf16(s[2 * 33], s[3 * 33]); o.z = cvt_pk_bf16(s[4 * 33], s[5 * 33]); o.w = cvt_pk_bf16(s[6 * 33], s[7 * 33]);
        const int dr = drow0 + n;
        bf16_t* dst = blk ? WT + (size_t)(dr >> 8) * 256 * ldt + (size_t)(k0 >> 6) * (256 * 64) + (dr & 255) * 64 + 8 * c
                          : WT + (size_t)dr * ldt + k0 + 8 * c;
        *(u32x4*)dst = o; }
    LDS_WAIT(); asm volatile("" ::: "memory");
}
__device__ __forceinline__ void tr_matrix(int& base, int gw, int NGW, const float* W, int K, int N, int ldw, const float* gain, bf16_t* WT, int ldt, int grp, int gstride, int goff,
                                          int skip_lo, int skip_hi, LAS float* scr, int lane, int blk = 0) {
    const int nblk = N / 32, nkb = K / 64 - (skip_hi - skip_lo), cnt = nkb * nblk;
    int first = (gw - base) % NGW; if (first < 0) first += NGW;
    float va[32], vb[32];
    int it = first;
#define TR_DECODE(IT, K0, N0) int K0, N0; { int kb = (IT) / nblk; const int nb = (IT) % nblk; if (kb >= skip_lo) kb += skip_hi - skip_lo; K0 = kb * 64; N0 = nb * 32; }
    if (it < cnt) { TR_DECODE(it, k0, n0); tr_load(W, ldw, gain, k0, n0, lane, va); }
    while (it < cnt) {
        TR_DECODE(it, k0, n0);
        const int it2 = it + NGW;
        if (it2 < cnt) { TR_DECODE(it2, k2, n2); tr_load(W, ldw, gain, k2, n2, lane, vb); }
        tr_store(va, WT, ldt, k0, (n0 / grp) * gstride + goff + (n0 % grp), scr, lane, blk);
        it = it2;
        if (it >= cnt) break;
        { TR_DECODE(it, k1, n1);
          const int it3 = it + NGW;
          if (it3 < cnt) { TR_DECODE(it3, k3, n3); tr_load(W, ldw, gain, k3, n3, lane, va); }
          tr_store(vb, WT, ldt, k1, (n1 / grp) * gstride + goff + (n1 % grp), scr, lane, blk);
          it = it3; }
    }
#undef TR_DECODE
    base = (base + cnt) % NGW;
}

__device__ __forceinline__ void p0a(LAS unsigned char* lds, int tid, int lane, int wave, int bid, int G) {
    KArgs a = kargs();
    unsigned char* ws = a->ws;
    LAS float* scr = (LAS float*)(lds + wave * 16384);
    const int gw = bid * 8 + wave, NGW = G * 8;
    int base = 0;
    for (int l = 0; l < ((REP_MASK >> 16) & 1 ? 4 : 2); ++l) {
        unsigned char* wl = ws + WS_WL + (size_t)(l & 1) * WL_STRIDE;
        const int BIG = 1 << 30;
        tr_matrix(base, gw, NGW, a->in[I_F1G] + (size_t)(l & 1) * D * DFF, D, DFF, DFF, a->in[I_F1N] + (l & 1) * D, (bf16_t*)(wl + WL_GU1), D, 128, 256, 0, 0, 0, scr, lane);
        tr_matrix(base, gw, NGW, a->in[I_F1U] + (size_t)(l & 1) * D * DFF, D, DFF, DFF, a->in[I_F1N] + (l & 1) * D, (bf16_t*)(wl + WL_GU1), D, 128, 256, 128, 0, 0, scr, lane);
        tr_matrix(base, gw, NGW, a->in[I_F1D] + (size_t)(l & 1) * DFF * D, DFF, D, D, nullptr, (bf16_t*)(wl + WL_D1), DFF, BIG, 0, 0, 0, 0, scr, lane, 1);
        tr_matrix(base, gw, NGW, a->in[I_F2G] + (size_t)(l & 1) * D * DFF, D, DFF, DFF, a->in[I_F2N] + (l & 1) * D, (bf16_t*)(wl + WL_GU2), D, 128, 256, 0, 0, 0, scr, lane);
        tr_matrix(base, gw, NGW, a->in[I_F2U] + (size_t)(l & 1) * D * DFF, D, DFF, DFF, a->in[I_F2N] + (l & 1) * D, (bf16_t*)(wl + WL_GU2), D, 128, 256, 128, 0, 0, scr, lane);
        tr_matrix(base, gw, NGW, a->in[I_F2D] + (size_t)(l & 1) * DFF * D, DFF, D, D, nullptr, (bf16_t*)(wl + WL_D2), DFF, BIG, 0, 0, 0, 0, scr, lane, 1);
        tr_matrix(base, gw, NGW, a->in[I_WIN] + (size_t)(l & 1) * D * DIN, D, DIN, DIN, a->in[I_MIXN] + (l & 1) * D, (bf16_t*)(wl + WL_IN), D, BIG, 0, 0, 0, 0, scr, lane);
        tr_matrix(base, gw, NGW, a->in[I_WOUT] + (size_t)(l & 1) * D * D, D, D, D, nullptr, (bf16_t*)(wl + WL_OUT), D, BIG, 0, 0, 6, 10, scr, lane);
        tr_matrix(base, gw, NGW, a->in[I_WQ] + (size_t)(l & 1) * D * D, D, D, D, a->in[I_XN] + (l & 1) * D, (bf16_t*)(wl + WL_Q), D, BIG, 0, 0, 0, 0, scr, lane);
        tr_matrix(base, gw, NGW, a->in[I_WK] + (size_t)(l & 1) * D * D, D, D, D, a->in[I_MN] + (l & 1) * D, (bf16_t*)(wl + WL_K), D, BIG, 0, 0, 0, 0, scr, lane);
        tr_matrix(base, gw, NGW, a->in[I_WV] + (size_t)(l & 1) * D * D, D, D, D, a->in[I_MN] + (l & 1) * D, (bf16_t*)(wl + WL_V), D, BIG, 0, 0, 0, 0, scr, lane);
        tr_matrix(base, gw, NGW, a->in[I_WO] + (size_t)(l & 1) * D * D, D, D, D, nullptr, (bf16_t*)(wl + WL_O), D, BIG, 0, 0, 0, 0, scr, lane);
        tr_matrix(base, gw, NGW, a->in[I_WGLU] + (size_t)(l & 1) * DSSM * DSSM, DSSM, DSSM, DSSM, nullptr, (bf16_t*)(wl + WL_GLU), DSSM, BIG, 0, 0, 0, 0, scr, lane);
    }
    const int gt = bid * 512 + tid, NGT = G * 512;
    for (int _r = 0; _r < ((REP_MASK >> 17) & 1 ? 2 : 1); ++_r)
    for (int it = gt; it < 2 * DPOOL * D; it += NGT) {
        const int n = it & (D - 1), c = (it >> 10) & (DPOOL - 1), l = it >> 18, g = c >> 6;
        const float* pw = a->in[I_PW] + ((size_t)(l * 4 + g) * 64 + (c & 63)) * 64; const float* ps = a->in[I_PS] + l * DPOOL + g * 64;
        const float* wo = a->in[I_WOUT] + (size_t)l * D * D + (size_t)(DSSM + g * 64) * D + n;
        float s = 0.f;
#pragma unroll 8
        for (int d = 0; d < 64; ++d) s += pw[d] * ps[d] * wo[(size_t)d * D];
        ((bf16_t*)(ws + WS_WL + (size_t)l * WL_STRIDE + WL_OUT))[(size_t)n * D + DSSM + c] = (bf16_t)(cvt_pk_bf16(s, 0.f) & 0xffffu);
    }
    for (int _r = 0; _r < ((REP_MASK >> 17) & 1 ? 2 : 1); ++_r)
    for (int it = gt; it < 2 * NGR * 128 * (NTOK / 8); it += NGT) {
        const int k8 = it % (NTOK / 8), r = (it / (NTOK / 8)) & 127, gl = it / (128 * (NTOK / 8)), g = gl % NGR, l = gl / NGR, p = r & 63, s = k8 >> 1, i0 = (k8 & 1) * 8;
        const float lr = a->in[I_LRE][(l * NGR + g) * NP + p], li = a->in[I_LIM][(l * NGR + g) * NP + p], dt = expf(a->in[I_LDT][l * NGR + g]);
        float zr, zi, pr, pi; zcoef(lr, li, dt, zr, zi); lam_pow(lr, li, dt, (float)(CH - 1 - s), pr, pi);
        const float wr_ = pr * zr - pi * zi, wi_ = pr * zi + pi * zr;
        const float* br = a->in[I_BRE] + ((size_t)(l * NGR + g) * NP + p) * SG + i0; const float* bi = a->in[I_BIM] + ((size_t)(l * NGR + g) * NP + p) * SG + i0;
        float v[8];
#pragma unroll
        for (int e = 0; e < 8; ++e) v[e] = (r < 64) ? (wr_ * br[e] - wi_ * bi[e]) : (wr_ * bi[e] + wi_ * br[e]);
        u32x4 o; o.x = cvt_pk_bf16(v[0], v[1]); o.y = cvt_pk_bf16(v[2], v[3]); o.z = cvt_pk_bf16(v[4], v[5]); o.w = cvt_pk_bf16(v[6], v[7]);
        *(u32x4*)((bf16_t*)(ws + WS_WL + (size_t)l * WL_STRIDE + WL_GM) + ((size_t)(g * 128 + r) * NTOK + k8 * 8)) = o;
    }
    for (int row = gw; row < M + MM; row += 2 * NGW) {
        const int row2 = row + NGW; const bool has2 = row2 < M + MM;
        f32x4 v[2][4];
#pragma unroll
        for (int q = 0; q < 2; ++q) { const int rr = q ? row2 : row; if (q && !has2) break; const bool isx = rr < M; const int r = isx ? rr : rr - M;
            const f32x4* src = (const f32x4*)((isx ? a->in[I_X] : a->in[I_MEM]) + (size_t)r * D);
#pragma unroll
            for (int j = 0; j < 4; ++j) v[q][j] = __builtin_nontemporal_load(src + lane + 64 * j); }
#pragma unroll
        for (int q = 0; q < 2; ++q) { const int rr = q ? row2 : row; if (q && !has2) break; const bool isx = rr < M; const int r = isx ? rr : rr - M;
            bf16_t* dst = (bf16_t*)(ws + (isx ? WS_XB : WS_MEMB)) + (size_t)r * D;
            float s = 0.f;
#pragma unroll
            for (int j = 0; j < 4; ++j) { const f32x4 x = v[q][j]; s += (x[0] * x[0] + x[1] * x[1]) + (x[2] * x[2] + x[3] * x[3]);
                u32x2 w; w.x = cvt_pk_bf16(x[0], x[1]); w.y = cvt_pk_bf16(x[2], x[3]); *(u32x2*)(dst + (lane + 64 * j) * 4) = w; }
            s = wave_sum(s);
            if (isx) { if (lane < 16) ((float*)(ws + WS_SSQ))[(size_t)r * 16 + lane] = lane == 0 ? s : 0.f; }
            else if (lane == 0) ((float*)(ws + WS_RSMEM))[r] = rsqrtf(s * (1.f / D) + EPS); }
    }
    LAS float* Wr = (LAS float*)lds; LAS float* Wi = Wr + 2 * NP * SG; LAS float* Cr = Wi + 2 * NP * SG; LAS float* Ci = Cr + SG * NP;
    for (int _r = 0; _r < ((REP_MASK >> 17) & 1 ? 2 : 1); ++_r)
    for (int it = bid; it < 2 * NGR * (CH / 2); it += G) {
        const int kp = it % (CH / 2), g = (it / (CH / 2)) % NGR, l = (it / (CH / 2)) / NGR;
        __syncthreads();
        if (tid < 128) {
            const int kk = tid >> 6, p = tid & 63;
            const float lr = a->in[I_LRE][(l * NGR + g) * NP + p], li = a->in[I_LIM][(l * NGR + g) * NP + p], dt = expf(a->in[I_LDT][l * NGR + g]);
            float zr, zi, pr, pi; zcoef(lr, li, dt, zr, zi); lam_pow(lr, li, dt, (float)(2 * kp + kk), pr, pi);
            const float wr_ = pr * zr - pi * zi, wi_ = pr * zi + pi * zr;
            const f32x4* br = (const f32x4*)(a->in[I_BRE] + ((size_t)(l * NGR + g) * NP + p) * SG); const f32x4* bi = (const f32x4*)(a->in[I_BIM] + ((size_t)(l * NGR + g) * NP + p) * SG);
#pragma unroll
            for (int i4 = 0; i4 < 4; ++i4) { const f32x4 b_r = br[i4], b_i = bi[i4];
                *(LAS f32x4*)(Wr + (kk * NP + p) * SG + 4 * i4) = b_r * wr_ - b_i * wi_; *(LAS f32x4*)(Wi + (kk * NP + p) * SG + 4 * i4) = b_i * wr_ + b_r * wi_; }
        } else if (tid < 384) {
            const int q = tid - 128;
            *(LAS f32x4*)(Cr + q * 4) = *(const f32x4*)(a->in[I_CRE] + (size_t)(l * NGR + g) * SG * NP + q * 4);
            *(LAS f32x4*)(Ci + q * 4) = *(const f32x4*)(a->in[I_CIM] + (size_t)(l * NGR + g) * SG * NP + q * 4);
        }
        __syncthreads();
        const int kk = tid >> 8, o = (tid >> 4) & 15, i = tid & 15;
        float s = 0.f;
#pragma unroll 16
        for (int p = 0; p < NP; ++p) s += Cr[o * NP + p] * Wr[(kk * NP + p) * SG + i] - Ci[o * NP + p] * Wi[(kk * NP + p) * SG + i];
        ((float*)(ws + WS_KTAB))[(((size_t)(l * NGR + g) * 64 + 2 * kp + kk) * SG + o) * SG + i] = s;
    }
    __syncthreads();
}

__device__ __forceinline__ void mix_side(int l, LAS unsigned char* lds, int tid, int lane, int wave, int bid, int G) {
    asm volatile("" : "+v"(tid), "+v"(lane));
    KArgs a = kargs();
    unsigned char* ws = a->ws;
    {
        bf16_t* tc = (bf16_t*)(ws + WS_TCAT); const float* kt = (const float*)(ws + WS_KTAB) + (size_t)l * NGR * 64 * 256;
        const int nskip = (GROWS / BM < G) ? GROWS / BM : 0, vb = bid - nskip, VG = G - nskip;
        if (vb >= 0) {
#pragma unroll 4
            for (int it = vb * 512 + tid; it < NGR * NTOK * (NTOK / 8); it += VG * 512) {
                const int k8 = it % (NTOK / 8) + 16, n = (it / (NTOK / 8)) % NTOK, g = it / (NTOK * (NTOK / 8)), t = n >> 4, o = n & 15;
                const int kk = k8 * 8 - 128, s = kk >> 4, i0 = kk & 15, lag = t - s;
                if ((s >> 4) > (t >> 4)) continue;
                u32x4 w = {0u, 0u, 0u, 0u};
                if (lag >= 0) { const float* q = kt + ((size_t)(g * 64 + lag) * SG + o) * SG + i0; w = pack8(*(const f32x4*)q, *(const f32x4*)(q + 4)); }
                *(u32x4*)(tc + ((size_t)(g * NTOK + n) * KCAT + k8 * 8)) = w;
            }
            for (int it = vb * 512 + tid; it < NGR * NTOK * 16; it += VG * 512) {
                const int k8 = it & 15, n = (it >> 4) % NTOK, g = it / (NTOK * 16), t = n >> 4, o = n & 15;
                const int p0 = (k8 * 8) & 63; const bool im = k8 >= 8;
                const float dt = expf(a->in[I_LDT][l * NGR + g]);
                float v[8];
#pragma unroll
                for (int e = 0; e < 8; ++e) {
                    const int p = p0 + e;
                    const float lr = a->in[I_LRE][(l * NGR + g) * NP + p], li = a->in[I_LIM][(l * NGR + g) * NP + p];
                    const float cr = a->in[I_CRE][((size_t)(l * NGR + g) * SG + o) * NP + p], ci = a->in[I_CIM][((size_t)(l * NGR + g) * SG + o) * NP + p];
                    float pr, pi; lam_pow(lr, li, dt, (float)(t + 1), pr, pi);
                    v[e] = im ? -(cr * pi + ci * pr) : (cr * pr - ci * pi);
                }
                u32x4 w; w.x = cvt_pk_bf16(v[0], v[1]); w.y = cvt_pk_bf16(v[2], v[3]); w.z = cvt_pk_bf16(v[4], v[5]); w.w = cvt_pk_bf16(v[6], v[7]);
                *(u32x4*)(tc + ((size_t)(g * NTOK + n) * KCAT + k8 * 8)) = w;
            }
        }
    }
    const bf16_t* zpc = (const bf16_t*)(ws + WS_ZPC); bf16_t* ymix = (bf16_t*)(ws + WS_YMIX);
    const int pskip = (GROWS / BM < G) ? GROWS / BM : 0;
    if (bid >= pskip)
    for (int it = (bid - pskip) * 512 + tid; it < (M / 64) * 4 * 64; it += (G - pskip) * 512) {
        const int ln = it & 63, g4 = (it >> 6) & 3, tbhi = it >> 8, tb = tbhi * 8 + (ln >> 3), c8 = g4 * 64 + (ln & 7) * 8, row0 = tb * 8, t0 = row0 & (S - 1);
        const int w = 2 << g4;
        f32x4 p0[24], p1[24];
#pragma unroll
        for (int i = 0; i < 24; ++i) {
            f32x4 x0 = {0.f, 0.f, 0.f, 0.f}, x1 = x0;
            if (i >= 16 - w && i > 0 && t0 - 16 + i >= 0) unpack8(*(const u32x4*)(zpc + (size_t)(row0 - 16 + i) * D + c8), x0, x1);
            if (i == 0) { p0[0] = x0; p1[0] = x1; } else { p0[i] = p0[i - 1] + x0; p1[i] = p1[i - 1] + x1; }
        }
#pragma unroll
        for (int tt = 0; tt < 8; ++tt) {
            const int i = 16 + tt, t = t0 + tt, n = (t + 1 < w) ? t + 1 : w; const float inv = 1.f / (float)n;
            f32x4 lo0, lo1;
            if (w == 2) { lo0 = p0[i - 2]; lo1 = p1[i - 2]; } else if (w == 4) { lo0 = p0[i - 4]; lo1 = p1[i - 4]; } else if (w == 8) { lo0 = p0[i - 8]; lo1 = p1[i - 8]; } else { lo0 = p0[i - 16]; lo1 = p1[i - 16]; }
            const f32x4 u0 = p0[i] - p0[i - 1], u1 = p1[i] - p1[i - 1];
            *(u32x4*)(ymix + (size_t)(row0 + tt) * D + DSSM + c8) = pack8((p0[i] - lo0) * inv - u0, (p1[i] - lo1) * inv - u1);
        }
    }
    LAS float* hs = (LAS float*)lds;
    LAS float* cs = hs + 62 * DCONV;
    const float* cw = a->in[I_CW] + (size_t)l * CW * DCONV; const float* cb = a->in[I_CB] + l * DCONV;
    const float* lg = a->in[I_LNG] + l * DCONV; const float* lb = a->in[I_LNB] + l * DCONV;
    float lgk[6], lbk[6];
#pragma unroll
    for (int e = 0; e < 6; ++e) { lgk[e] = lg[lane * 6 + e]; lbk[e] = lb[lane * 6 + e]; }
    float wj[CW]; float bias;
    { const int c = tid % DCONV; bias = cb[c];
#pragma unroll
      for (int j = 0; j < CW; ++j) wj[j] = cw[j * DCONV + c]; }
    for (int tile = bid; tile < M / 32; tile += G) {
        const int row0 = tile * 32, t0 = row0 & (S - 1);
        __syncthreads();
        for (int it = tid; it < 62 * 48; it += 512) {
            const int r = it / 48, c8 = (it % 48) * 8, t = t0 - 30 + r;
            f32x4 h0 = {0.f, 0.f, 0.f, 0.f}, h1 = h0;
            if (t >= 0) {
                f32x4 v0, v1, g0, g1;
                unpack8(*(const u32x4*)(zpc + (size_t)(row0 - 30 + r) * D + DPOOL + c8), v0, v1);
                unpack8(*(const u32x4*)(zpc + (size_t)(row0 - 30 + r) * D + DPOOL + DCONV + c8), g0, g1);
#pragma unroll
                for (int e = 0; e < 4; ++e) { h0[e] = v0[e] * fsigm(g0[e]); h1[e] = v1[e] * fsigm(g1[e]); }
            }
            *(LAS f32x4*)(hs + r * DCONV + c8) = h0; *(LAS f32x4*)(hs + r * DCONV + c8 + 4) = h1;
        }
        __syncthreads();
        if (tid < DCONV) {
            const int c = tid;
#pragma unroll
            for (int half = 0; half < 2; ++half) {
                float hv[46];
#pragma unroll
                for (int i = 0; i < 46; ++i) hv[i] = hs[(half * 16 + i) * DCONV + c];
#pragma unroll
                for (int t = 0; t < 16; ++t) { float o = bias;
#pragma unroll
                    for (int j = 0; j < CW; ++j) o += wj[j] * hv[t + j];
                    cs[(half * 16 + t) * DCONV + c] = o; }
            }
        }
        __syncthreads();
#pragma unroll
        for (int q = 0; q < 4; ++q) {
            const int tt = wave * 4 + q; float v[6]; float s = 0.f;
#pragma unroll
            for (int e = 0; e < 6; ++e) { v[e] = cs[tt * DCONV + lane * 6 + e]; s += v[e]; }
            const float mu = wave_sum(s) * (1.f / DCONV); float qq = 0.f;
#pragma unroll
            for (int e = 0; e < 6; ++e) { v[e] -= mu; qq += v[e] * v[e]; }
            const float r = rsqrtf(wave_sum(qq) * (1.f / DCONV) + EPS);
#pragma unroll
            for (int e = 0; e < 6; ++e) { const float h = v[e] * r * lgk[e] + lbk[e]; v[e] = h * fsigm(h); }
            unsigned* op = (unsigned*)(ymix + (size_t)(row0 + tt) * D + DSSM + DPOOL + lane * 6);
            op[0] = cvt_pk_bf16(v[0], v[1]); op[1] = cvt_pk_bf16(v[2], v[3]); op[2] = cvt_pk_bf16(v[4], v[5]);
        }
    }
    __syncthreads();
}

template <class SchedT>
__device__ __forceinline__ void s2_local(int l, const SchedT& Sd, int tid) {
    asm volatile("" : "+v"(tid));
    KArgs a = kargs();
    unsigned char* ws = a->ws;
    const float* xloc = (const float*)(ws + WS_XLOC); bf16_t* ucat = (bf16_t*)(ws + WS_UCAT);
    Unit u; int prev = -1;
    for (int i = 0; Sd.next(i, u); ++i) {
        if (u.pm == prev) continue;
        prev = u.pm;
        if (tid < 256) {
            const int p = tid & 63, g = u.pm / (NCH / BM), b = (u.pm % (NCH / BM)) * (BM / (S / CH)) + (tid >> 6);
            const float lr = a->in[I_LRE][(l * NGR + g) * NP + p], li = a->in[I_LIM][(l * NGR + g) * NP + p], dt = expf(a->in[I_LDT][l * NGR + g]);
            float ar, ai; lam_pow(lr, li, dt, (float)CH, ar, ai);
            float xr = 0.f, xi = 0.f;
#pragma unroll 1
            for (int h = 0; h < S / CH / 32; ++h) {
                const size_t rowb = (size_t)g * NCH + b * (S / CH) + h * 32;
                float lr_[32], li_[32];
#pragma unroll
                for (int c = 0; c < 32; ++c) { lr_[c] = xloc[(rowb + c) * 128 + p]; li_[c] = xloc[(rowb + c) * 128 + 64 + p]; }
#pragma unroll
                for (int c = 0; c < 32; ++c) {
                    ucat[(rowb + c) * KCAT + p] = (bf16_t)(cvt_pk_bf16(xr, 0.f) & 0xffffu); ucat[(rowb + c) * KCAT + 64 + p] = (bf16_t)(cvt_pk_bf16(xi, 0.f) & 0xffffu);
                    const float nr = ar * xr - ai * xi + lr_[c], ni = ar * xi + ai * xr + li_[c]; xr = nr; xi = ni;
                }
            }
        }
    }
    asm volatile("s_waitcnt vmcnt(0)" ::: "memory");
    __syncthreads();
}

__device__ __forceinline__ void final_norm(int lane, int wave, int bid, int G) {
    KArgs a = kargs();
    const float* ssq = (const float*)(a->ws + WS_SSQ); const f32x4* gn = (const f32x4*)a->in[I_FN]; const bf16_t* xb = (const bf16_t*)(a->ws + WS_XB);
    const f32x4 g0 = gn[lane * 2], g1 = gn[lane * 2 + 1], g2 = gn[128 + lane * 2], g3 = gn[128 + lane * 2 + 1];
    for (int row = bid * 8 + wave; row < M; row += G * 8) {
        float s = lane < 16 ? ssq[(size_t)row * 16 + lane] : 0.f; s = wave_sum(s);
        const float r = rsqrtf(s * (1.f / D) + EPS);
        const u32x4 w0 = *(const u32x4*)(xb + (size_t)row * D + lane * 8), w1 = *(const u32x4*)(xb + (size_t)row * D + 512 + lane * 8);
        f32x4 a0, a1, b0, b1; unpack8(w0, a0, a1); unpack8(w1, b0, b1);
        f32x4* o = (f32x4*)(a->out + (size_t)row * D);
        __builtin_nontemporal_store(a0 * r * g0, o + lane * 2); __builtin_nontemporal_store(a1 * r * g1, o + lane * 2 + 1); __builtin_nontemporal_store(b0 * r * g2, o + 128 + lane * 2); __builtin_nontemporal_store(b1 * r * g3, o + 128 + lane * 2 + 1);
    }
}
#ifndef MK_CG_ALL
#define MK_CG_ALL 0
#endif
constexpr int N_PHASES = 31;
__global__ void __launch_bounds__(512, 2) mk_fwd(Args a) {
    extern __shared__ __attribute__((aligned(16))) unsigned char lds_raw[];
    LAS unsigned char* lds = (LAS unsigned char*)lds_raw;
    cg::grid_group grid = cg::this_grid();
    const int tid = threadIdx.x, lane = tid & 63, wave = __builtin_amdgcn_readfirstlane(tid >> 6), bid = blockIdx.x, G = gridDim.x;
    unsigned char* ws = kargs()->ws;
    volatile LAS unsigned* misc = (volatile LAS unsigned*)(lds + MISC_OFF);
    if (tid < 16) misc[tid] = 0u;
    __syncthreads();
    XcdBarrier bar = xcd_barrier_post((unsigned*)(ws + WS_CTL), misc);
    const int lo = kargs()->ph_lo, hi = kargs()->ph_hi;
#define PH(k) if (lo <= (k) && (k) < hi)
#ifndef REP_MASK
#define REP_MASK 0
#endif
#define PHK(k, kind) for (int _r = 0; _r < ((((REP_MASK) >> (kind)) & 1) ? 2 : 1); ++_r) if (lo <= (k) && (k) < hi)
#define SEAM(k) do { if (lo <= (k) && (k) + 1 < hi) { if (MK_CG_ALL) grid.sync(); else { xcd_barrier(bar); if ((REP_MASK >> 10) & 1) xcd_barrier(bar); } } } while (0)
    const size_t RT1024 = 524288;
    float* ssq = (float*)(ws + WS_SSQ); bf16_t* xb = (bf16_t*)(ws + WS_XB);

    if (lo < 0) grid.sync();
    PHK(0, 0) { p0a(lds, tid, lane, wave, bid, G); }
    SEAM(0);
    PHK(1, 1) {
        Gemm g{ws, ws, D, D, D, 0, 0}; Sched S; S.init(1, 256, G, bid); S.kv = 1; S.kv_memb = WS_MEMB;
        S.kv_wk0 = WS_WL + WL_K; S.kv_wk1 = WS_WL + WL_STRIDE + WL_K; S.kv_wv0 = WS_WL + WL_V; S.kv_wv1 = WS_WL + WL_STRIDE + WL_V;
        EpiKV E{(bf16_t*)(ws + WS_KV), (bf16_t*)(ws + WS_KV + 16 * MiB), (const float*)(ws + WS_RSMEM)};
        gemm_phase(lds, g, S, E);
    }
#pragma unroll 1
    for (int l = 0; l < 2; ++l) {
        const int pb = 2 + 14 * l;
        unsigned char* wl = ws + WS_WL + (size_t)l * WL_STRIDE;
#pragma unroll 1
        for (int f = 0; f < 2; ++f) {
            const int p0 = pb + (f ? 12 : 0);
            PHK(p0, 2) {
                Gemm g{ws + WS_XB, wl + (f ? WL_GU2 : WL_GU1), D, D, D, 0, 0}; Sched S; S.init(M / BM, 2 * DFF / BM, G, bid); S.aM = RT1024; S.bN = RT1024;
                EpiSwiglu E{(bf16_t*)(ws + WS_ACT), ssq};
                gemm_phase(lds, g, S, E);
            }
            SEAM(p0);
            PHK(p0 + 1, 9) {
                Gemm g{ws + WS_ACT, wl + (f ? WL_D2 : WL_D1), DFF, DFF, DFF, 1, 1}; Sched S; S.init(M / BM, D / BM, G, bid); S.aM = (size_t)BM * DFF * 2; S.bN = (size_t)BM * DFF * 2;
                EpiResid E{xb, ssq, ((REP_MASK >> 9) & 1) ? 0.25f : 0.5f};
                gemm_phase(lds, g, S, E);
            }
            SEAM(p0 + 1);
            if (f == 1) break;
            PHK(pb + 2, 3) {
                Gemm g{ws + WS_XB, wl + WL_IN, D, D, D, 0, 0}; Sched S; S.init(M / BM, 6, G, bid); S.aM = RT1024; S.bN = RT1024;
                EpiWin E{(bf16_t*)(ws + WS_UCAT), (bf16_t*)(ws + WS_ZPC), ssq};
                gemm_phase(lds, g, S, E);
            }
            SEAM(pb + 2);
            PHK(pb + 3, 4) {
                Gemm g{ws + WS_UCAT, wl + WL_GM, KCAT, NTOK, NTOK, 0, 0}; Sched S; S.init(GROWS / BM, 1, G, bid); S.a0 = 256; S.aM = (size_t)BM * KCAT * 2; S.bdiv = NCH / BM; S.bM = (size_t)128 * NTOK * 2;
                EpiXloc E{(float*)(ws + WS_XLOC)};
                gemm_phase(lds, g, S, E);
                mix_side(l, lds, tid, lane, wave, bid, G);
            }
            SEAM(pb + 3);
            PHK(pb + 5, 6) {
                Gemm g{ws + WS_UCAT, ws + WS_TCAT, KCAT, KCAT, KCAT, 0, 0}; Sched S; S.init(GROWS / BM, NTOK / BM, G, bid); S.aM = (size_t)BM * KCAT * 2; S.bN = (size_t)BM * KCAT * 2; S.bdiv = NCH / BM; S.bM = (size_t)(NTOK / BM) * BM * KCAT * 2; S.causal = 1;
                s2_local(l, S, tid);
                EpiS5 E{(const bf16_t*)(ws + WS_UCAT), (bf16_t*)(ws + WS_YG), kargs()->in[I_SD] + l * DSSM};
                gemm_phase(lds, g, S, E);
            }
            SEAM(pb + 5);
            PHK(pb + 6, 7) {
                Gemm g{ws + WS_YG, wl + WL_GLU, DSSM, DSSM, DSSM, 0, 0}; Sched S; S.init(M / BM, 2, G, bid); S.aM = (size_t)BM * DSSM * 2; S.bN = (size_t)BM * DSSM * 2;
                EpiGlu E{(const bf16_t*)(ws + WS_YG), (bf16_t*)(ws + WS_YMIX)};
                gemm_phase(lds, g, S, E);
            }
            SEAM(pb + 6);
            PH(pb + 7) {
                Gemm g{ws + WS_YMIX, wl + WL_OUT, D, D, D, 0, 0}; Sched S; S.init(M / BM, D / BM, G, bid); S.aM = RT1024; S.bN = RT1024;
                EpiResid E{xb, ssq, 1.0f};
                gemm_phase(lds, g, S, E);
            }
            SEAM(pb + 7);
            PHK(pb + 8, 8) {
                Gemm g{ws + WS_XB, wl + WL_Q, D, D, D, 0, 0}; Sched S; S.init(M / BM, D / BM, G, bid); S.aM = RT1024; S.bN = RT1024;
                EpiRowScale E{(bf16_t*)(ws + WS_Q), D, ssq};
                gemm_phase(lds, g, S, E);
            }
            PHK(pb + 9, 11) {
                Gemm g{ws + WS_Q, ws + WS_KV + (size_t)l * 8 * MiB, D, D, 256, 0, 0}; Sched S; S.init(M / BM, 4, G, bid); S.aM = RT1024; S.aN = 512; S.bN = 512; S.bdiv = 8; S.bM = RT1024;
                EpiSoftmax E{(bf16_t*)(ws + WS_YMIX)};
                gemm_phase(lds, g, S, E);
            }
            PHK(pb + 10, 12) {
                Gemm g{ws + WS_YMIX, ws + WS_KV + (size_t)(2 + l) * 8 * MiB, D, MM, 256, 0, 0}; Sched S; S.init(M / BM, 4, G, bid); S.aM = RT1024; S.aN = 512; S.bN = (size_t)BM * MM * 2; S.bdiv = 8; S.bM = 512;
                EpiRowScale E{(bf16_t*)(ws + WS_Q), D, nullptr};
                gemm_phase(lds, g, S, E);
            }
            SEAM(pb + 10);
            PH(pb + 11) {
                Gemm g{ws + WS_Q, wl + WL_O, D, D, D, 0, 0}; Sched S; S.init(M / BM, D / BM, G, bid); S.aM = RT1024; S.bN = RT1024;
                EpiResid E{xb, ssq, 1.0f};
                gemm_phase(lds, g, S, E);
            }
            SEAM(pb + 11);
        }
    }
    PH(30) { final_norm(lane, wave, bid, G); }
#undef PH
#undef SEAM
}
}

#ifndef ENG_PHASES
#define ENG_PHASES 31
#endif
extern "C" void kernel_launch(void* const* d_in, const int* in_sizes, int n_in, void* d_out, int out_size, void* d_ws, size_t ws_size, hipStream_t stream) {
    static int grid = 0;
    if (grid == 0) {
        int dev = 0, cus = 0, per_cu = 0;
        if (ws_size < mk::WS_END || n_in != 35) { fprintf(stderr, "kernel_launch: bad ws/n_in\n"); grid = -1; return; }
        hipGetDevice(&dev); hipDeviceGetAttribute(&cus, hipDeviceAttributeMultiprocessorCount, dev);
        if (hipFuncSetAttribute((const void*)mk::mk_fwd, hipFuncAttributeMaxDynamicSharedMemorySize, mk::LDS_BYTES) != hipSuccess) { fprintf(stderr, "kernel_launch: hipFuncSetAttribute failed\n"); grid = -1; return; }
        if (hipOccupancyMaxActiveBlocksPerMultiprocessor(&per_cu, (const void*)mk::mk_fwd, 512, mk::LDS_BYTES) != hipSuccess || per_cu < 1) fprintf(stderr, "kernel_launch: occupancy query says %d\n", per_cu);
        (void)hipGetLastError();
        grid = cus;
    }
    if (grid < 0) return;
    hipMemsetAsync((char*)d_ws + mk::WS_CTL, 0, 16384, stream);
    mk::Args a; memset(&a, 0, sizeof(a));
    for (int i = 0; i < 35; ++i) a.in[i] = (const float*)d_in[i];
    a.out = (float*)d_out; a.ws = (unsigned char*)d_ws; a.ph_lo = 0; a.ph_hi = ENG_PHASES;
    void* args[] = {&a};
    hipError_t e = hipLaunchCooperativeKernel((const void*)mk::mk_fwd, dim3(grid), dim3(512), args, mk::LDS_BYTES, stream);
    if (e != hipSuccess) fprintf(stderr, "cooperative launch failed: %s (grid %d)\n", hipGetErrorString(e), grid);
#if ENG_PHASES < 31
    {
        const nv::In I = nv::make_in(d_in); float* x = (float*)d_out; float* ws = (float*)d_ws;
        int st = 0;
        for (int l = 0; l < 2; ++l) { const int pb = 2 + 14 * l; if (ENG_PHASES >= pb + 2) st = 4 * l + 1; if (ENG_PHASES >= pb + 8) st = 4 * l + 2; if (ENG_PHASES >= pb + 12) st = 4 * l + 3; if (ENG_PHASES >= pb + 14) st = 4 * l + 4; }
        if (st == 0) hipLaunchKernelGGL(nv::copy_k, dim3(4096), dim3(256), 0, stream, (const float4*)I.x, (float4*)x, (size_t)nv::M * nv::D / 4);
        for (int s = st; s < 8; ++s) {
            const int l = s >> 2, k = s & 3;
            if (k == 0) nv::ffn(stream, x, ws, I.ffn1_norm + l * 1024, I.ffn1_wg + (size_t)l * 1024 * 2816, I.ffn1_wu + (size_t)l * 1024 * 2816, I.ffn1_wd + (size_t)l * 2816 * 1024);
            else if (k == 1) nv::mixer(stream, x, ws, I, l);
            else if (k == 2) nv::xattn(stream, x, ws, I, l);
            else nv::ffn(stream, x, ws, I.ffn2_norm + l * 1024, I.ffn2_wg + (size_t)l * 1024 * 2816, I.ffn2_wu + (size_t)l * 1024 * 2816, I.ffn2_wd + (size_t)l * 2816 * 1024);
        }
        hipLaunchKernelGGL(nv::rmsnorm_k, dim3(nv::M / 4), dim3(256), 0, stream, x, I.final_norm, x, nv::M);
    }
#endif
}
```
